# Optimizing an MI355X kernel written in HIP

```python
import jax
import jax.numpy as jnp
from jax import lax
import numpy as np

D_MODEL = 1024
BATCH = 8
SEQ = 8192
DEPTH = 1
DEC_BATCH = 16
DEC_SEQ = 64
PAST_LEN = 1024

CHUNK = 64
EPS = 1e-6
ROPE_THETA = 10000.0
N_HEADS_A = 8
N_KV_A = 2
GROUP_A = N_HEADS_A // N_KV_A
HD_A = 64
D_ATT_A = N_HEADS_A * HD_A
D_KV_A = N_KV_A * HD_A
N_IDX_HEADS = 8
D_IDX = 32
D_QIDX = N_IDX_HEADS * D_IDX
IDX_SCALE = (N_IDX_HEADS * D_IDX) ** -0.5
TOPK_MAX = 256
Q_BLOCK = 128
POOL_WINDOWS = (2, 4, 8, 16)
N_POOL_GROUPS = 4
POOL_GROUP = 128
D_POOL = N_POOL_GROUPS * POOL_GROUP
POOL_HIST = 15
N_MEM = 256
N_HEADS_M = 4
HD_M = 128
D_MEM_ATT = N_HEADS_M * HD_M
N_BRANCH = 3
D_FF = -(-(8 * D_MODEL) // (3 * 256)) * 256
IN_WIDTHS = (D_ATT_A, D_KV_A, D_KV_A, D_QIDX, D_IDX, N_IDX_HEADS, D_POOL, D_MEM_ATT, N_BRANCH * D_MODEL)
D_IN = D_ATT_A + 2 * D_KV_A + D_QIDX + D_IDX + N_IDX_HEADS + D_POOL + D_MEM_ATT + N_BRANCH * D_MODEL

kernel_name = 'hybrid_dsa_pool_memory_streaming_step'


def rmsnorm(x, g):
    x32 = x.astype(jnp.float32)
    y = x32 * lax.rsqrt(jnp.mean(x32 * x32, axis=-1, keepdims=True) + EPS)
    return (y * g.astype(jnp.float32)).astype(x.dtype)


def rope(x, pos):
    half = x.shape[-1] // 2
    inv = ROPE_THETA ** (-jnp.arange(half, dtype=jnp.float32) / half)
    ang = pos.astype(jnp.float32)[:, None] * inv[None, :]
    cos = jnp.cos(ang)[None, :, None, :]
    sin = jnp.sin(ang)[None, :, None, :]
    x32 = x.astype(jnp.float32)
    x1, x2 = x32[..., :half], x32[..., half:]
    return jnp.concatenate([x1 * cos - x2 * sin, x2 * cos + x1 * sin], axis=-1).astype(x.dtype)


def project_inputs(x, pos, g_mix, w_in, g_qa, g_ka, g_kidx, g_qm):
    B, T, _ = x.shape
    h = rmsnorm(x, g_mix)
    p = h @ w_in
    cuts = [int(c) for c in np.cumsum(IN_WIDTHS)[:-1]]
    qa, ka, va, qi, ki, wi, ub, qm, gates = jnp.split(p, cuts, axis=-1)
    qa = rope(rmsnorm(qa.reshape(B, T, N_HEADS_A, HD_A), g_qa), pos)
    ka = rope(rmsnorm(ka.reshape(B, T, N_KV_A, HD_A), g_ka), pos)
    va = va.reshape(B, T, N_KV_A, HD_A)
    qi = rope(qi.reshape(B, T, N_IDX_HEADS, D_IDX), pos)
    ki = rope(rmsnorm(ki, g_kidx)[:, :, None, :], pos)[:, :, 0, :]
    wi = wi * IDX_SCALE
    qm = rmsnorm(qm.reshape(B, T, N_HEADS_M, HD_M), g_qm)
    return qa, ka, va, qi, ki, wi, ub, qm, gates


def dsa_attend(qa, qi, wi, qpos, ka, va, ki, topk):
    B, Tq = qa.shape[:2]
    n_keys = ka.shape[1]
    s = jax.nn.relu(jnp.einsum('bthd,bsd->bths', qi, ki, preferred_element_type=jnp.float32))
    score = jnp.einsum('bths,bth->bts', s, wi.astype(jnp.float32))
    q_chunk = qpos // CHUNK
    adm = (jnp.arange(n_keys) // CHUNK)[None, :] <= q_chunk[:, None]
    score = jnp.where(adm[None], score, -jnp.inf)
    _, sel = lax.top_k(score, topk)
    gather_rows = jax.vmap(lambda rows, i: rows[i])
    k_sel = gather_rows(ka, sel)
    v_sel = gather_rows(va, sel)
    valid = (sel // CHUNK) <= q_chunk[None, :, None]
    q = qa.reshape(B, Tq, N_KV_A, GROUP_A, HD_A)
    logits = jnp.einsum('bthgd,btjhd->bthgj', q, k_sel, preferred_element_type=jnp.float32) * (HD_A ** -0.5)
    logits = jnp.where(valid[:, :, None, None, :], logits, -jnp.inf)
    probs = jax.nn.softmax(logits, axis=-1).astype(va.dtype)
    out = jnp.einsum('bthgj,btjhd->bthgd', probs, v_sel)
    return out.reshape(B, Tq, D_ATT_A)


def dsa_prompt(qa, qi, wi, pos, ka, va, ki, topk):
    B, T = qa.shape[:2]
    nblk = T // Q_BLOCK

    def to_blocks(a):
        return jnp.moveaxis(a.reshape((B, nblk, Q_BLOCK) + a.shape[2:]), 1, 0)

    def one_block(args):
        qa_b, qi_b, wi_b, pos_b = args
        return dsa_attend(qa_b, qi_b, wi_b, pos_b, ka, va, ki, topk)

    out = lax.map(one_block, (to_blocks(qa), to_blocks(qi), to_blocks(wi), pos.reshape(nblk, Q_BLOCK)))
    return jnp.moveaxis(out, 0, 1).reshape(B, T, D_ATT_A)


def pool_mix(u_ext, pos0, w_pool, s_pool):
    B, n, _ = u_ext.shape
    T = n - POOL_HIST
    u = u_ext[:, POOL_HIST:]
    cs = jnp.cumsum(u_ext.astype(jnp.float32), axis=1)
    cs = jnp.concatenate([jnp.zeros_like(cs[:, :1]), cs], axis=1)
    pos = pos0 + jnp.arange(T, dtype=jnp.int32)
    means = []
    for g, w in enumerate(POOL_WINDOWS):
        c = slice(g * POOL_GROUP, (g + 1) * POOL_GROUP)
        win = cs[:, POOL_HIST + 1:, c] - cs[:, POOL_HIST + 1 - w:POOL_HIST + 1 - w + T, c]
        cnt = jnp.minimum(w, pos + 1).astype(jnp.float32)[None, :, None]
        means.append(win / cnt)
    mean = jnp.concatenate(means, axis=-1)
    p = (mean - u.astype(jnp.float32)).astype(u.dtype).reshape(B, T, N_POOL_GROUPS, POOL_GROUP)
    y = jnp.einsum('btgc,gce->btge', p, w_pool).reshape(B, T, D_POOL)
    return y * s_pool


def memory_kv(mem, g_mem, w_mem_kv, g_km):
    B, M, _ = mem.shape
    kv = rmsnorm(mem, g_mem) @ w_mem_kv
    k, v = jnp.split(kv, 2, axis=-1)
    k = rmsnorm(k.reshape(B, M, N_HEADS_M, HD_M), g_km)
    return k, v.reshape(B, M, N_HEADS_M, HD_M)


def memory_attend(qm, mk, mv):
    B, T = qm.shape[:2]
    logits = jnp.einsum('bthd,bmhd->bhtm', qm, mk, preferred_element_type=jnp.float32) * (HD_M ** -0.5)
    probs = jax.nn.softmax(logits, axis=-1).astype(mv.dtype)
    return jnp.einsum('bhtm,bmhd->bthd', probs, mv).reshape(B, T, D_MEM_ATT)


def merge_and_ffn(x, a, b, m, gates, w_oa, w_ob, w_om, w_out, g_ffn, w_gate, w_up, w_down):
    ga, gb, gm = jnp.split(jax.nn.sigmoid(gates.astype(jnp.float32)).astype(x.dtype), N_BRANCH, axis=-1)
    mixed = ga * (a @ w_oa) + gb * (b @ w_ob) + gm * (m @ w_om)
    x = x + mixed @ w_out
    h = rmsnorm(x, g_ffn)
    return x + (jax.nn.silu(h @ w_gate) * (h @ w_up)) @ w_down


def setup_inputs(seed: int = 0) -> dict:
    key = jax.random.key(seed)
    ks = jax.random.split(key, 32)
    f32 = jnp.float32
    L = DEPTH

    def nrm(k, shape, scale):
        return jax.random.normal(k, shape, f32) * scale

    def gain(k, shape):
        return 1.0 + 0.1 * jax.random.normal(k, shape, f32)

    return {
        'x_prompt': nrm(ks[0], (BATCH, SEQ, D_MODEL), 1.0),
        'x_sample': nrm(ks[1], (DEC_BATCH, DEC_SEQ, D_MODEL), 1.0),
        'mem_prompt': nrm(ks[2], (BATCH, N_MEM, D_MODEL), 1.0),
        'cache_a_k': nrm(ks[3], (L, DEC_BATCH, PAST_LEN, N_KV_A, HD_A), 1.0),
        'cache_a_v': nrm(ks[4], (L, DEC_BATCH, PAST_LEN, N_KV_A, HD_A), 1.0),
        'cache_idx_k': nrm(ks[5], (L, DEC_BATCH, PAST_LEN, D_IDX), 1.0),
        'cache_pool': nrm(ks[6], (L, DEC_BATCH, POOL_HIST, D_POOL), 1.0),
        'cache_mem_k': nrm(ks[7], (L, DEC_BATCH, N_MEM, N_HEADS_M, HD_M), 1.0),
        'cache_mem_v': nrm(ks[8], (L, DEC_BATCH, N_MEM, N_HEADS_M, HD_M), 1.0),
        'g_mix': gain(ks[9], (L, D_MODEL)),
        'w_in': nrm(ks[10], (L, D_MODEL, D_IN), D_MODEL ** -0.5),
        'g_qa': gain(ks[11], (L, HD_A)),
        'g_ka': gain(ks[12], (L, HD_A)),
        'g_kidx': gain(ks[13], (L, D_IDX)),
        'g_qm': gain(ks[14], (L, HD_M)),
        'g_mem': gain(ks[15], (L, D_MODEL)),
        'w_mem_kv': nrm(ks[16], (L, D_MODEL, 2 * D_MEM_ATT), D_MODEL ** -0.5),
        'g_km': gain(ks[17], (L, HD_M)),
        'w_pool': nrm(ks[18], (L, N_POOL_GROUPS, POOL_GROUP, POOL_GROUP), POOL_GROUP ** -0.5),
        's_pool': gain(ks[19], (L, D_POOL)),
        'w_oa': nrm(ks[20], (L, D_ATT_A, D_MODEL), D_ATT_A ** -0.5),
        'w_ob': nrm(ks[21], (L, D_POOL, D_MODEL), D_POOL ** -0.5),
        'w_om': nrm(ks[22], (L, D_MEM_ATT, D_MODEL), D_MEM_ATT ** -0.5),
        'w_out': nrm(ks[23], (L, D_MODEL, D_MODEL), D_MODEL ** -0.5),
        'g_ffn': gain(ks[24], (L, D_MODEL)),
        'w_gate': nrm(ks[25], (L, D_MODEL, D_FF), D_MODEL ** -0.5),
        'w_up': nrm(ks[26], (L, D_MODEL, D_FF), D_MODEL ** -0.5),
        'w_down': nrm(ks[27], (L, D_FF, D_MODEL), D_FF ** -0.5),
    }


def reference(x_prompt, x_sample, mem_prompt, cache_a_k, cache_a_v, cache_idx_k, cache_pool, cache_mem_k,
              cache_mem_v, g_mix, w_in, g_qa, g_ka, g_kidx, g_qm, g_mem, w_mem_kv, g_km, w_pool, s_pool,
              w_oa, w_ob, w_om, w_out, g_ffn, w_gate, w_up, w_down):
    T = x_prompt.shape[1]
    TS = x_sample.shape[1]
    P = cache_a_k.shape[2]
    pos_p = jnp.arange(T, dtype=jnp.int32)
    pos_s = P + jnp.arange(TS, dtype=jnp.int32)
    topk_p = min(TOPK_MAX, T // 4)
    topk_s = min(TOPK_MAX, (P + TS) // 4)
    xp, xs = x_prompt, x_sample
    ak_p, av_p, ik_p, pool_p, mk_p, mv_p = [], [], [], [], [], []
    ak_s, av_s, ik_s, pool_s = [], [], [], []
    for l in range(DEPTH):
        qa, ka, va, qi, ki, wi, ub, qm, gates = project_inputs(xp, pos_p, g_mix[l], w_in[l], g_qa[l], g_ka[l], g_kidx[l], g_qm[l])
        a = dsa_prompt(qa, qi, wi, pos_p, ka, va, ki, topk_p)
        ub_ext = jnp.pad(ub, ((0, 0), (POOL_HIST, 0), (0, 0)))
        b = pool_mix(ub_ext, 0, w_pool[l], s_pool[l])
        mk, mv = memory_kv(mem_prompt, g_mem[l], w_mem_kv[l], g_km[l])
        m = memory_attend(qm, mk, mv)
        xp = merge_and_ffn(xp, a, b, m, gates, w_oa[l], w_ob[l], w_om[l], w_out[l], g_ffn[l], w_gate[l], w_up[l], w_down[l])
        ak_p.append(ka)
        av_p.append(va)
        ik_p.append(ki)
        pool_p.append(ub[:, -POOL_HIST:])
        mk_p.append(mk)
        mv_p.append(mv)
        qa, ka, va, qi, ki, wi, ub, qm, gates = project_inputs(xs, pos_s, g_mix[l], w_in[l], g_qa[l], g_ka[l], g_kidx[l], g_qm[l])
        k_all = jnp.concatenate([cache_a_k[l], ka], axis=1)
        v_all = jnp.concatenate([cache_a_v[l], va], axis=1)
        ki_all = jnp.concatenate([cache_idx_k[l], ki], axis=1)
        a = dsa_attend(qa, qi, wi, pos_s, k_all, v_all, ki_all, topk_s)
        ub_ext = jnp.concatenate([cache_pool[l], ub], axis=1)
        b = pool_mix(ub_ext, P, w_pool[l], s_pool[l])
        m = memory_attend(qm, cache_mem_k[l], cache_mem_v[l])
        xs = merge_and_ffn(xs, a, b, m, gates, w_oa[l], w_ob[l], w_om[l], w_out[l], g_ffn[l], w_gate[l], w_up[l], w_down[l])
        ak_s.append(ka)
        av_s.append(va)
        ik_s.append(ki)
        pool_s.append(ub_ext[:, -POOL_HIST:])
    y_prompt = xp
    y_sample = xs
    new_a_k_prompt = jnp.stack(ak_p)
    new_a_v_prompt = jnp.stack(av_p)
    new_idx_k_prompt = jnp.stack(ik_p)
    new_pool_prompt = jnp.stack(pool_p)
    new_mem_k_prompt = jnp.stack(mk_p)
    new_mem_v_prompt = jnp.stack(mv_p)
    new_a_k_sample = jnp.stack(ak_s)
    new_a_v_sample = jnp.stack(av_s)
    new_idx_k_sample = jnp.stack(ik_s)
    new_pool_sample = jnp.stack(pool_s)
    return (y_prompt, y_sample, new_a_k_prompt, new_a_v_prompt, new_idx_k_prompt, new_pool_prompt, new_mem_k_prompt, new_mem_v_prompt, new_a_k_sample, new_a_v_sample, new_idx_k_sample, new_pool_sample)
```

```cpp
#include <hip/hip_runtime.h>
#include <hip/hip_cooperative_groups.h>
#include <cstdint>
#include <cstdio>
namespace cg = cooperative_groups;

#define LAS __attribute__((address_space(3)))
typedef unsigned short bf16_t;
typedef short bf16x8 __attribute__((ext_vector_type(8)));
typedef float f32x4 __attribute__((ext_vector_type(4)));
typedef float f32x16 __attribute__((ext_vector_type(16)));
typedef unsigned u32x4 __attribute__((ext_vector_type(4)));
typedef unsigned u32x2 __attribute__((ext_vector_type(2)));

constexpr int MP = 65536, MS = 1024, MT = MP + MS;
constexpr int DM = 1024, NIN = 5376, DFF = 2816, NGU = 2 * DFF;
constexpr int SKEYS = 1088;
constexpr float EPS = 1e-6f;

constexpr size_t O_Y = 0, O_AKP = 68157440, O_AVP = 76546048, O_IKP = 84934656, O_PLP = 87031808, O_MKP = 87093248, O_MVP = 88141824,
                 O_AKS = 89190400, O_AVS = 89321472, O_IKS = 89452544, O_PLS = 89485312;

constexpr size_t MiB = 1u << 20;
constexpr size_t WS_CTL = 0;
constexpr size_t WS_WIN = 1 * MiB;
constexpr size_t WS_WMEM = 12 * MiB;
constexpr size_t WS_WPOOL = 14 * MiB;
constexpr size_t WS_WOA = 15 * MiB, WS_WOB = 16 * MiB, WS_WOM = 17 * MiB;
constexpr size_t WS_WOUT = 18 * MiB;
constexpr size_t WS_WGU = 20 * MiB;
constexpr size_t WS_WDN = 31 * MiB;
constexpr size_t WS_MEMN = 37 * MiB;
constexpr size_t WS_KVMEM = 41 * MiB;
constexpr size_t WS_MKB = 45 * MiB;
constexpr size_t WS_MVT = 51 * MiB;
constexpr size_t WS_KVS = 57 * MiB;
constexpr size_t WS_KIS = 66 * MiB;
constexpr size_t WS_KI = 68 * MiB;
constexpr size_t WS_WI = 73 * MiB;
constexpr size_t WS_KW32 = 76 * MiB;
constexpr size_t WS_H = 93 * MiB;
constexpr size_t WS_QA = 223 * MiB;
constexpr size_t WS_KV = 288 * MiB;
constexpr size_t WS_QI = 321 * MiB;
constexpr size_t WS_UB = 354 * MiB;
constexpr size_t WS_QM = 419 * MiB;
constexpr size_t WS_PP = 484 * MiB;
constexpr size_t WS_G = 549 * MiB;
constexpr size_t WS_KV8 = 940 * MiB;
constexpr size_t WS_QA8 = 958 * MiB;
constexpr size_t WS_KVS8 = 991 * MiB;
constexpr size_t WS_QL = 996 * MiB;
constexpr size_t WS_WDN2 = 1001 * MiB;
constexpr size_t WS_END = 1007 * MiB;

constexpr int LDS_BYTES = 163840;

namespace pg8 {
constexpr int BM = 256, BK = 64, HALF = 128, HTB = HALF * BK * 2, NXCD = 8, WGM = 4;
__device__ __forceinline__ void stage_rc(int b, int& R, int& C) { const int st = b / 1024, sb = b % 1024, swz = sb ^ (((sb >> 9) & 1) << 5); R = (st >> 1) * 16 + swz / 64; C = (st & 1) * 32 + (swz % 64) / 2; }
__device__ __forceinline__ int lds_byte(int r, int c) { const int st = (r >> 4) * 2 + (c >> 5), rr = r & 15, cc = c & 31, ob = rr * 64 + cc * 2; return st * 1024 + (ob ^ (((ob >> 9) & 1) << 5)); }
__device__ __forceinline__ int perm32(int rho) { const int n = rho >> 4, i = rho & 15; return 8 * (i >> 2) + 4 * n + (i & 3); }
struct Unit { int pm, pn, sub; };
struct Gemm { const bf16_t* A; const bf16_t* Bt; int M, N, K, lda, ldb, a_pn_off; const bf16_t *A1, *A2, *B1, *B2; int a_pn_shift; };
struct StaticOrder {
    int nM, nN, nwg, G, c;
    __device__ void init(int M, int N, int G_, int c_) { nM = M / BM; nN = N / BM; nwg = nM * nN; G = G_; c = c_; }
    __device__ bool next(int i, Unit& u) const {
        const long L = (long)i * G + c; if (L >= nwg) return false;
        int wgid = (int)L; { const int q = nwg / NXCD, r = nwg % NXCD, xcd = wgid % NXCD, off = wgid / NXCD; wgid = (xcd < r ? xcd * (q + 1) : r * (q + 1) + (xcd - r) * q) + off; }
        const int nig = WGM * nN, gid = wgid / nig, fm = gid * WGM, gsz = (nM - fm) < WGM ? (nM - fm) : WGM;
        u.pm = fm + ((wgid % nig) % gsz); u.pn = (wgid % nig) / gsz; u.sub = 0; return true;
    }
};
struct ChainOrder3 {
    StaticOrder base;
    __device__ bool next(int i, Unit& u) const { if (!base.next(i / 3, u)) return false; u.sub = i % 3; return true; }
};
__device__ __forceinline__ unsigned cvt_pk_bf16(float lo, float hi) { unsigned r; asm volatile("v_cvt_pk_bf16_f32 %0, %1, %2" : "=v"(r) : "v"(lo), "v"(hi)); return r; }

template <class Epi, class Sched>
__device__ __forceinline__ void gemm_phase(LAS unsigned char* lds, const Gemm g, const Sched& S, const Epi& E) {
    const int tid = threadIdx.x, wid = __builtin_amdgcn_readfirstlane(tid >> 6), lane = tid & 63, wr = wid >> 2, wc = wid & 3, fr = lane & 15, fq = lane >> 4;
    const int K = g.K, nt = K / BK;
    unsigned voffA[2], voffB[2];
#pragma unroll
    for (int i = 0; i < 2; ++i) { int R, C; stage_rc(tid * 16 + i * 8192, R, C); const int Rb = (R & ~31) + perm32(R & 31);
        voffA[i] = (unsigned)(R * g.lda + C) * 2u; voffB[i] = (unsigned)(Rb * g.ldb + C) * 2u; }
    const size_t kstep = (size_t)(BK * 2);
    const size_t hstepA = (size_t)HALF * g.lda * 2, hstepB = (size_t)HALF * g.ldb * 2;
    const size_t tstepA = 2 * hstepA, tstepB = 2 * hstepB;
    const unsigned ldsw = (unsigned)wid * 1024u;
    const int aoff = lds_byte(wr * 64 + fr, fq * 8), boff = lds_byte(wc * 32 + fr, fq * 8);
#define PG8_SA(b, h) (((b) * 2 + (h)) * HTB)
#define PG8_SB(b, h) ((4 + (b) * 2 + (h)) * HTB)
#define PG8_STAGE(bufoff, gbase, voff) do { _Pragma("unroll") for (int _i = 0; _i < 2; ++_i) \
        __builtin_amdgcn_global_load_lds((const unsigned*)((const char*)(gbase) + (voff)[_i]), (LAS unsigned*)(lds + (bufoff) + ldsw + _i * 8192), 16, 0, 0); } while (0)
#define PG8_LDA(dst, b, h) do { _Pragma("unroll") for (int m = 0; m < 4; ++m) _Pragma("unroll") for (int k = 0; k < 2; ++k) dst[m][k] = *(const LAS bf16x8*)(lds + PG8_SA(b, h) + aoff + m * 2048 + k * 1024); } while (0)
#define PG8_LDB(dst, b, h) do { _Pragma("unroll") for (int n = 0; n < 2; ++n) _Pragma("unroll") for (int k = 0; k < 2; ++k) dst[n][k] = *(const LAS bf16x8*)(lds + PG8_SB(b, h) + boff + n * 2048 + k * 1024); } while (0)
#define PG8_MMA(ai, bj, At, Bt) do { __builtin_amdgcn_s_setprio(1); _Pragma("unroll") for (int m = 0; m < 4; ++m) _Pragma("unroll") for (int n = 0; n < 2; ++n) _Pragma("unroll") for (int k = 0; k < 2; ++k) \
        acc[ai][bj][m][n] = __builtin_amdgcn_mfma_f32_16x16x32_bf16(Bt[n][k], At[m][k], acc[ai][bj][m][n], 0, 0, 0); __builtin_amdgcn_s_setprio(0); } while (0)
#define PG8_WAIT_V(n) asm volatile("s_waitcnt vmcnt(" #n ")" ::: "memory")
#define PG8_WAIT_L(n) asm volatile("s_waitcnt lgkmcnt(" #n ")" ::: "memory")
#define PG8_BAR __builtin_amdgcn_s_barrier()
#define PG8_SCHED __builtin_amdgcn_sched_barrier(0)
    Unit cur, nxt; int ui = 0;
    if (!S.next(0, cur)) return;
    f32x4 acc[2][2][4][2];
#pragma unroll
    for (int a = 0; a < 2; ++a)
#pragma unroll
        for (int b = 0; b < 2; ++b)
#pragma unroll
            for (int m = 0; m < 4; ++m)
#pragma unroll
                for (int n = 0; n < 2; ++n) acc[a][b][m][n] = (f32x4){0.f, 0.f, 0.f, 0.f};
    bf16x8 At[4][2], B0[2][2], B1[2][2];
#define PG8_ABASE(u_) ((const char*)((u_).sub == 0 ? g.A : ((u_).sub == 1 ? g.A1 : g.A2)) + (size_t)(u_).pm * tstepA + (size_t)((u_).pn >> g.a_pn_shift) * g.a_pn_off * 2)
#define PG8_BBASE(u_) ((const char*)((u_).sub == 0 ? g.Bt : ((u_).sub == 1 ? g.B1 : g.B2)) + (size_t)(u_).pn * tstepB)
    const char* cA = PG8_ABASE(cur); const char* cB = PG8_BBASE(cur);
    PG8_STAGE(PG8_SB(0, 0), cB, voffB); PG8_STAGE(PG8_SB(0, 1), cB + hstepB, voffB); PG8_STAGE(PG8_SA(0, 0), cA, voffA); PG8_STAGE(PG8_SA(0, 1), cA + hstepA, voffA);
    if (wr == 1) PG8_BAR;
    PG8_WAIT_V(2); PG8_BAR;
    PG8_STAGE(PG8_SB(1, 0), cB + kstep, voffB); PG8_STAGE(PG8_SA(1, 0), cA + kstep, voffA); PG8_STAGE(PG8_SB(1, 1), cB + hstepB + kstep, voffB);
    PG8_WAIT_V(6); PG8_BAR;
    for (;;) {
        const bool has_next = S.next(ui + 1, nxt);
        const char* nA = has_next ? PG8_ABASE(nxt) : cA; const char* nB = has_next ? PG8_BBASE(nxt) : cB;
        for (int t = 0; t < nt; t += 2) {
            const bool last = (t == nt - 2);
            const char* a1 = cA + (size_t)(t + 1) * kstep;
            const char* a2 = last ? nA : cA + (size_t)(t + 2) * kstep; const char* b2 = last ? nB : cB + (size_t)(t + 2) * kstep;
            const char* a3 = a2 + kstep; const char* b3 = b2 + kstep;
            PG8_LDB(B0, 0, 0); PG8_LDB(B1, 0, 1); PG8_SCHED; PG8_LDA(At, 0, 0); PG8_STAGE(PG8_SA(1, 1), a1 + hstepA, voffA);
            PG8_WAIT_V(8); PG8_WAIT_L(0); PG8_BAR; PG8_MMA(0, 0, At, B0); PG8_MMA(0, 1, At, B1); PG8_BAR; PG8_SCHED;
            PG8_LDA(At, 0, 1); PG8_STAGE(PG8_SB(0, 0), b2, voffB); PG8_STAGE(PG8_SB(0, 1), b2 + hstepB, voffB); PG8_STAGE(PG8_SA(0, 0), a2, voffA);
            PG8_WAIT_V(8); PG8_WAIT_L(0); PG8_BAR; PG8_MMA(1, 0, At, B0); PG8_MMA(1, 1, At, B1); PG8_BAR; PG8_SCHED;
            PG8_LDB(B0, 1, 0); PG8_LDB(B1, 1, 1); PG8_SCHED; PG8_LDA(At, 1, 0); PG8_STAGE(PG8_SA(0, 1), a2 + hstepA, voffA);
            PG8_WAIT_V(8); PG8_WAIT_L(0); PG8_BAR; PG8_MMA(0, 0, At, B0); PG8_MMA(0, 1, At, B1); PG8_BAR; PG8_SCHED;
            PG8_LDA(At, 1, 1); PG8_STAGE(PG8_SB(1, 0), b3, voffB); PG8_STAGE(PG8_SB(1, 1), b3 + hstepB, voffB); PG8_STAGE(PG8_SA(1, 0), a3, voffA);
            PG8_WAIT_V(8); PG8_WAIT_L(0); PG8_BAR; PG8_MMA(1, 0, At, B0); PG8_MMA(1, 1, At, B1); PG8_BAR; PG8_SCHED;
        }
        if (wr == 0) PG8_BAR;
        E(acc, cur, wr, wc, fr, fq);
        if (!has_next) break;
        if (!Epi::CHAIN || cur.sub == 2) {
#pragma unroll
        for (int a = 0; a < 2; ++a)
#pragma unroll
            for (int b = 0; b < 2; ++b)
#pragma unroll
                for (int m = 0; m < 4; ++m)
#pragma unroll
                    for (int n = 0; n < 2; ++n) acc[a][b][m][n] = (f32x4){0.f, 0.f, 0.f, 0.f};
        }
        cur = nxt; cA = nA; cB = nB; ++ui;
        if (wr == 1) PG8_BAR;
    }
    PG8_WAIT_V(0);
    PG8_BAR;
#undef PG8_ABASE
#undef PG8_BBASE
#undef PG8_SA
#undef PG8_SB
#undef PG8_STAGE
#undef PG8_LDA
#undef PG8_LDB
#undef PG8_MMA
#undef PG8_WAIT_V
#undef PG8_WAIT_L
#undef PG8_BAR
#undef PG8_SCHED
}
}
using pg8::cvt_pk_bf16;

enum { EP_INPROJ = 0, EP_BF16, EP_MERGE0, EP_MERGE1, EP_MERGE2, EP_WOUT, EP_UP, EP_DOWN, EP_CHAIN, EP_DOWN_PART };
struct EpiArgs {
    bf16_t *QA, *KV, *QI, *UB, *QM, *G; float* KW32;
    bf16_t* O; int ldc; const float* cs;
    float* Y; const float* xp; const float* xs;
    bf16_t* HID;
    bf16_t* XG; float* SS; const float* gf;
};
__device__ __forceinline__ float sigmoidf_(float x) { return __builtin_amdgcn_rcpf(1.0f + __expf(-x)); }
__device__ __forceinline__ float bflo(unsigned u) { return __uint_as_float(u << 16); }
__device__ __forceinline__ float bfhi(unsigned u) { return __uint_as_float(u & 0xffff0000u); }

__device__ __forceinline__ void unpack8(const u32x4 q, float (&v)[8]);
template <int MODE> struct Epi {
    static constexpr bool CHAIN = (MODE == EP_CHAIN);
    EpiArgs p;
    __device__ __forceinline__ void operator()(f32x4 (&acc)[2][2][4][2], const pg8::Unit& u, int wr, int wc, int fr, int fq) const {
        const int row0 = u.pm * 256 + wr * 64 + fr, cw = wc * 32 + 8 * fq, pn = u.pn;
        if constexpr (MODE == EP_INPROJ) {
            if (pn == 4) {
                if (cw < 64) {
#pragma unroll
                    for (int ai = 0; ai < 2; ++ai)
#pragma unroll
                        for (int m = 0; m < 4; ++m) { float* d = p.KW32 + (size_t)(row0 + ai * 128 + m * 16) * 64 + cw;
                            *(f32x4*)d = acc[ai][0][m][0]; *(f32x4*)(d + 4) = acc[ai][0][m][1]; }
                }
                return;
            }
            bf16_t* base; int ld, co; bool sig = false;
            if (pn < 2) { base = p.QA; ld = 512; co = pn * 256; }
            else if (pn == 2) { base = p.KV; ld = 256; co = 0; }
            else if (pn == 3) { base = p.QI; ld = 256; co = 0; }
            else if (pn < 7) { base = p.UB; ld = 512; co = (pn - 5) * 256; }
            else if (pn < 9) { base = p.QM; ld = 512; co = (pn - 7) * 256; }
            else { base = p.G; ld = 3072; co = (pn - 9) * 256; sig = true; }
#pragma unroll
            for (int ai = 0; ai < 2; ++ai)
#pragma unroll
                for (int m = 0; m < 4; ++m) { bf16_t* rp = base + (size_t)(row0 + ai * 128 + m * 16) * ld + co + cw;
#pragma unroll
                    for (int bj = 0; bj < 2; ++bj) { f32x4 v0 = acc[ai][bj][m][0], v1 = acc[ai][bj][m][1];
                        if (sig) {
#pragma unroll
                            for (int e = 0; e < 4; ++e) { v0[e] = sigmoidf_(v0[e]); v1[e] = sigmoidf_(v1[e]); } }
                        u32x4 w; w.x = cvt_pk_bf16(v0[0], v0[1]); w.y = cvt_pk_bf16(v0[2], v0[3]); w.z = cvt_pk_bf16(v1[0], v1[1]); w.w = cvt_pk_bf16(v1[2], v1[3]);
                        *(u32x4*)(rp + bj * 128) = w; } }
        } else if constexpr (MODE == EP_BF16) {
#pragma unroll
            for (int ai = 0; ai < 2; ++ai)
#pragma unroll
                for (int m = 0; m < 4; ++m) { bf16_t* rp = p.O + (size_t)(row0 + ai * 128 + m * 16) * p.ldc + pn * 256 + cw;
#pragma unroll
                    for (int bj = 0; bj < 2; ++bj) { f32x4 v0 = acc[ai][bj][m][0], v1 = acc[ai][bj][m][1];
                        if (p.cs) { const float* c = p.cs + pn * 256 + bj * 128 + cw; v0 = v0 * *(const f32x4*)c; v1 = v1 * *(const f32x4*)(c + 4); }
                        u32x4 w; w.x = cvt_pk_bf16(v0[0], v0[1]); w.y = cvt_pk_bf16(v0[2], v0[3]); w.z = cvt_pk_bf16(v1[0], v1[1]); w.w = cvt_pk_bf16(v1[2], v1[3]);
                        *(u32x4*)(rp + bj * 128) = w; } }
        } else if constexpr (MODE == EP_MERGE0 || MODE == EP_MERGE1 || MODE == EP_MERGE2) {
            constexpr int kb = MODE - EP_MERGE0;
#pragma unroll
            for (int ai = 0; ai < 2; ++ai)
#pragma unroll
                for (int m = 0; m < 4; ++m) { const int row = row0 + ai * 128 + m * 16;
#pragma unroll
                    for (int bj = 0; bj < 2; ++bj) { const int col = pn * 256 + bj * 128 + cw;
                        const u32x4 gq = *(const u32x4*)(p.G + (size_t)row * 3072 + kb * 1024 + col);
                        f32x4 v0 = acc[ai][bj][m][0], v1 = acc[ai][bj][m][1];
                        v0[0] *= bflo(gq.x); v0[1] *= bfhi(gq.x); v0[2] *= bflo(gq.y); v0[3] *= bfhi(gq.y);
                        v1[0] *= bflo(gq.z); v1[1] *= bfhi(gq.z); v1[2] *= bflo(gq.w); v1[3] *= bfhi(gq.w);
                        float* y = p.Y + (size_t)row * 1024 + col;
                        if constexpr (kb == 0) { *(f32x4*)y = v0; *(f32x4*)(y + 4) = v1; }
                        else if constexpr (kb == 1) { *(f32x4*)y = *(const f32x4*)y + v0; *(f32x4*)(y + 4) = *(const f32x4*)(y + 4) + v1; }
                        else { v0 = v0 + *(const f32x4*)y; v1 = v1 + *(const f32x4*)(y + 4);
                            u32x4 w; w.x = cvt_pk_bf16(v0[0], v0[1]); w.y = cvt_pk_bf16(v0[2], v0[3]); w.z = cvt_pk_bf16(v1[0], v1[1]); w.w = cvt_pk_bf16(v1[2], v1[3]);
                            *(u32x4*)(p.G + (size_t)row * 3072 + col) = w; } } }
        } else if constexpr (MODE == EP_CHAIN) {
            const int sub = u.sub;
#pragma unroll
            for (int ai = 0; ai < 2; ++ai)
#pragma unroll
                for (int m = 0; m < 4; ++m) { const int row = row0 + ai * 128 + m * 16;
#pragma unroll
                    for (int bj = 0; bj < 2; ++bj) { const int col = pn * 256 + bj * 128 + cw;
                        bf16_t* gp = p.G + (size_t)row * 3072 + col;
                        float f[8];
                        if (sub == 2) { unpack8(*(const u32x4*)(gp + 2048), f); }
                        else { float nu[8], de[8]; unpack8(*(const u32x4*)(gp + sub * 1024), nu); unpack8(*(const u32x4*)(gp + (sub + 1) * 1024), de);
#pragma unroll
                            for (int e = 0; e < 8; ++e) f[e] = nu[e] * __builtin_amdgcn_rcpf(fmaxf(de[e], 1e-30f)); }
                        f32x4 v0 = acc[ai][bj][m][0], v1 = acc[ai][bj][m][1];
#pragma unroll
                        for (int e = 0; e < 4; ++e) { v0[e] *= f[e]; v1[e] *= f[4 + e]; }
                        acc[ai][bj][m][0] = v0; acc[ai][bj][m][1] = v1;
                        if (sub == 2) { u32x4 w; w.x = cvt_pk_bf16(v0[0], v0[1]); w.y = cvt_pk_bf16(v0[2], v0[3]); w.z = cvt_pk_bf16(v1[0], v1[1]); w.w = cvt_pk_bf16(v1[2], v1[3]);
                            *(u32x4*)gp = w; } } }
        } else if constexpr (MODE == EP_WOUT) {
#pragma unroll
            for (int ai = 0; ai < 2; ++ai)
#pragma unroll
                for (int m = 0; m < 4; ++m) { const int row = row0 + ai * 128 + m * 16;
                    const float* xr = row < MP ? p.xp + (size_t)row * 1024 : p.xs + (size_t)(row - MP) * 1024;
                    float ss = 0.f;
#pragma unroll
                    for (int bj = 0; bj < 2; ++bj) { const int col = pn * 256 + bj * 128 + cw;
                        const f32x4 a0 = *(const f32x4*)(xr + col) + acc[ai][bj][m][0], a1 = *(const f32x4*)(xr + col + 4) + acc[ai][bj][m][1];
                        ss += (a0[0] * a0[0] + a0[1] * a0[1]) + (a0[2] * a0[2] + a0[3] * a0[3]) + (a1[0] * a1[0] + a1[1] * a1[1]) + (a1[2] * a1[2] + a1[3] * a1[3]);
                        u32x4 w; w.x = cvt_pk_bf16(a0[0], a0[1]); w.y = cvt_pk_bf16(a0[2], a0[3]); w.z = cvt_pk_bf16(a1[0], a1[1]); w.w = cvt_pk_bf16(a1[2], a1[3]);
                        *(u32x4*)(p.XG + (size_t)row * 1024 + col) = w; }
                    ss += __shfl_xor(ss, 16); ss += __shfl_xor(ss, 32);
                    if (fq == 0) p.SS[(size_t)row * 16 + pn * 4 + wc] = ss; }
        } else if constexpr (MODE == EP_DOWN) {
#pragma unroll
            for (int ai = 0; ai < 2; ++ai)
#pragma unroll
                for (int m = 0; m < 4; ++m) { const int row = row0 + ai * 128 + m * 16;
#pragma unroll
                    for (int bj = 0; bj < 2; ++bj) { const int col = pn * 256 + bj * 128 + cw; float* y = p.Y + (size_t)row * 1024 + col;
                        float xv[8]; unpack8(*(const u32x4*)(p.XG + (size_t)row * 1024 + col), xv);
                        *(f32x4*)y = (f32x4){xv[0], xv[1], xv[2], xv[3]} + acc[ai][bj][m][0]; *(f32x4*)(y + 4) = (f32x4){xv[4], xv[5], xv[6], xv[7]} + acc[ai][bj][m][1]; } }
        } else if constexpr (MODE == EP_DOWN_PART) {
#pragma unroll
            for (int ai = 0; ai < 2; ++ai)
#pragma unroll
                for (int m = 0; m < 4; ++m) { const int rl = row0 + ai * 128 + m * 16;
#pragma unroll
                    for (int bj = 0; bj < 2; ++bj) { float* y = p.Y + ((size_t)(pn >> 2) * 1024 + rl) * 1024 + (pn & 3) * 256 + bj * 128 + cw;
                        *(f32x4*)y = acc[ai][bj][m][0]; *(f32x4*)(y + 4) = acc[ai][bj][m][1]; } }
        } else if constexpr (MODE == EP_UP) {
#pragma unroll
            for (int ai = 0; ai < 2; ++ai)
#pragma unroll
                for (int m = 0; m < 4; ++m) { const int row = row0 + ai * 128 + m * 16;
                    const f32x4* sp = (const f32x4*)(p.SS + (size_t)row * 16); const f32x4 q0 = sp[0], q1 = sp[1], q2 = sp[2], q3 = sp[3];
                    const float tot = ((q0[0] + q0[1]) + (q0[2] + q0[3])) + ((q1[0] + q1[1]) + (q1[2] + q1[3])) + ((q2[0] + q2[1]) + (q2[2] + q2[3])) + ((q3[0] + q3[1]) + (q3[2] + q3[3]));
                    const float rstd = rsqrtf(tot * (1.f / 1024.f) + EPS);
                    f32x4 v0, v1;
#pragma unroll
                    for (int e = 0; e < 4; ++e) { const float g0 = acc[ai][0][m][0][e] * rstd, g1 = acc[ai][0][m][1][e] * rstd;
                        v0[e] = g0 * sigmoidf_(g0) * (acc[ai][1][m][0][e] * rstd); v1[e] = g1 * sigmoidf_(g1) * (acc[ai][1][m][1][e] * rstd); }
                    u32x4 w; w.x = cvt_pk_bf16(v0[0], v0[1]); w.y = cvt_pk_bf16(v0[2], v0[3]); w.z = cvt_pk_bf16(v1[0], v1[1]); w.w = cvt_pk_bf16(v1[2], v1[3]);
                    *(u32x4*)(p.HID + (size_t)row * DFF + pn * 128 + cw) = w; }
        }
    }
};

__device__ __forceinline__ float wave_sum(float v) {
#pragma unroll
    for (int o = 1; o < 64; o <<= 1) v += __shfl_xor(v, o);
    return v;
}
__device__ __forceinline__ void sincos_red(float a, float& s, float& c) {
    const float k = rintf(a * 0.15915494309189535f);
    float r = fmaf(-k, 6.28125f, a);
    r = fmaf(-k, 1.9353071795864769e-3f, r);
    s = __sinf(r); c = __cosf(r);
}
__device__ __forceinline__ void unpack8(const u32x4 q, float (&v)[8]) {
    v[0] = bflo(q.x); v[1] = bfhi(q.x); v[2] = bflo(q.y); v[3] = bfhi(q.y); v[4] = bflo(q.z); v[5] = bfhi(q.z); v[6] = bflo(q.w); v[7] = bfhi(q.w);
}
__device__ __forceinline__ u32x4 pack8(const float (&v)[8]) {
    u32x4 w; w.x = cvt_pk_bf16(v[0], v[1]); w.y = cvt_pk_bf16(v[2], v[3]); w.z = cvt_pk_bf16(v[4], v[5]); w.w = cvt_pk_bf16(v[6], v[7]); return w;
}
__device__ __forceinline__ void rms_row_1024(const float* xr, const float* g, bf16_t* o, int lane) {
    const f32x4* x4 = (const f32x4*)xr + lane; f32x4 v[4]; float s = 0.f;
#pragma unroll
    for (int j = 0; j < 4; ++j) { v[j] = x4[64 * j]; s += (v[j].x * v[j].x + v[j].y * v[j].y) + (v[j].z * v[j].z + v[j].w * v[j].w); }
    const float rstd = rsqrtf(wave_sum(s) * (1.f / 1024.f) + EPS);
#pragma unroll
    for (int j = 0; j < 4; ++j) { const f32x4 gg = ((const f32x4*)g)[lane + 64 * j];
        u32x2 w; w.x = cvt_pk_bf16(v[j].x * rstd * gg.x, v[j].y * rstd * gg.y); w.y = cvt_pk_bf16(v[j].z * rstd * gg.z, v[j].w * rstd * gg.w);
        *(u32x2*)(o + 4 * lane + 256 * j) = w; }
}
__device__ __forceinline__ void transpose_item(const float* W, int N, int K, bf16_t* WT, int k0, int n0, int col, LAS float* scr, int lane, const float* kscale = nullptr) {
    float tv[32];
#pragma unroll
    for (int i = 0; i < 32; ++i) { const int kk = 2 * i + (lane >> 5); tv[i] = (col >= 0) ? W[(size_t)(k0 + kk) * N + col] : 0.f; }
#pragma unroll
    for (int i = 0; i < 32; ++i) { const int kk = 2 * i + (lane >> 5); scr[kk * 33 + (lane & 31)] = kscale ? tv[i] * kscale[k0 + kk] : tv[i]; }
    asm volatile("s_waitcnt lgkmcnt(0)" ::: "memory");
    const int c = lane & 7;
#pragma unroll
    for (int j = 0; j < 4; ++j) { const int n = (lane >> 3) + 8 * j; const LAS float* s = scr + (8 * c) * 33 + n;
        u32x4 o; o.x = cvt_pk_bf16(s[0 * 33], s[1 * 33]); o.y = cvt_pk_bf16(s[2 * 33], s[3 * 33]); o.z = cvt_pk_bf16(s[4 * 33], s[5 * 33]); o.w = cvt_pk_bf16(s[6 * 33], s[7 * 33]);
        *(u32x4*)(WT + (size_t)(n0 + n) * K + k0 + 8 * c) = o; }
    asm volatile("s_waitcnt lgkmcnt(0)" ::: "memory");
}
__device__ __forceinline__ int map_in(int n) {
    if (n < 1024) return n;
    if (n < 1280) return (n - 1024 < 40) ? n : -1;
    if (n < 1792) return 1064 + (n - 1280);
    if (n < 2304) return 1576 + (n - 1792);
    return 2088 + (n - 2304);
}

struct Args { const float* in[28]; float* out; unsigned char* ws; };

#define MFMA16(a, b, c) __builtin_amdgcn_mfma_f32_16x16x32_bf16((a), (b), (c), 0, 0, 0)
#define MFMA32(a, b, c) __builtin_amdgcn_mfma_f32_32x32x16_bf16((a), (b), (c), 0, 0, 0)
__device__ __forceinline__ bf16x8 pack_p(const f32x4 a, const f32x4 b) {
    u32x4 w; w.x = cvt_pk_bf16(a[0], a[1]); w.y = cvt_pk_bf16(a[2], a[3]); w.z = cvt_pk_bf16(b[0], b[1]); w.w = cvt_pk_bf16(b[2], b[3]);
    return __builtin_bit_cast(bf16x8, w);
}

__device__ __forceinline__ void mem_attn_item(const bf16_t* QM, const bf16_t* Kb  , const bf16_t* VTb  , bf16_t* Mo, int r0, int h, int lane) {
    const int c = lane & 15, q = lane >> 4;
    bf16x8 Bq[4];
#pragma unroll
    for (int ks = 0; ks < 4; ++ks) Bq[ks] = *(const bf16x8*)(QM + (size_t)(r0 + c) * 512 + h * 128 + 32 * ks + 8 * q);
    f32x4 S[16];
#pragma unroll
    for (int kt = 0; kt < 16; ++kt) {
        const bf16_t* kp = Kb + (size_t)(16 * kt + c) * 512 + h * 128 + 8 * q;
        f32x4 s = (f32x4){0.f, 0.f, 0.f, 0.f};
#pragma unroll
        for (int ks = 0; ks < 4; ++ks) s = MFMA16(*(const bf16x8*)(kp + 32 * ks), Bq[ks], s);
        S[kt] = s;
    }
    const float sc = 0.08838834764831845f * 1.4426950408889634f;
    float mx = -3.0e38f;
#pragma unroll
    for (int kt = 0; kt < 16; ++kt)
#pragma unroll
        for (int e = 0; e < 4; ++e) mx = fmaxf(mx, S[kt][e]);
    mx = fmaxf(mx, __shfl_xor(mx, 16)); mx = fmaxf(mx, __shfl_xor(mx, 32));
    float sum = 0.f;
#pragma unroll
    for (int kt = 0; kt < 16; ++kt)
#pragma unroll
        for (int e = 0; e < 4; ++e) { const float pe = __builtin_amdgcn_exp2f((S[kt][e] - mx) * sc); S[kt][e] = pe; sum += pe; }
    sum += __shfl_xor(sum, 16); sum += __shfl_xor(sum, 32);
    const float inv = 1.0f / sum;
    f32x4 O[8];
#pragma unroll
    for (int dt = 0; dt < 8; ++dt) O[dt] = (f32x4){0.f, 0.f, 0.f, 0.f};
#pragma unroll
    for (int u = 0; u < 8; ++u) {
        const bf16x8 Bp = pack_p(S[2 * u] * inv, S[2 * u + 1] * inv);
#pragma unroll
        for (int dt = 0; dt < 8; ++dt) {
            const bf16_t* vp = VTb + (size_t)(16 * dt + c) * 256 + 32 * u + 4 * q;
            const u32x2 lo = *(const u32x2*)vp, hi = *(const u32x2*)(vp + 16);
            u32x4 w; w.x = lo.x; w.y = lo.y; w.z = hi.x; w.w = hi.y;
            O[dt] = MFMA16(__builtin_bit_cast(bf16x8, w), Bp, O[dt]);
        }
    }
#pragma unroll
    for (int dt = 0; dt < 8; ++dt) { u32x2 w; w.x = cvt_pk_bf16(O[dt][0], O[dt][1]); w.y = cvt_pk_bf16(O[dt][2], O[dt][3]);
        *(u32x2*)(Mo + (size_t)(r0 + c) * 512 + h * 128 + 16 * dt + 4 * q) = w; }
}

__device__ __forceinline__ void sparse_attn_query(const bf16_t* QA, const bf16_t* kvb, bf16_t* Ao, int row, const LAS unsigned short* sel, int ntile, int lane) {
    const int c = lane & 15, q = lane >> 4;
#pragma unroll 1
    for (int g = 0; g < 2; ++g) {
        bf16x8 Bq[2];
#pragma unroll
        for (int ks = 0; ks < 2; ++ks) { u32x4 z = (u32x4){0u, 0u, 0u, 0u};
            if (c < 4) z = *(const u32x4*)(QA + (size_t)row * 512 + (4 * g + c) * 64 + 32 * ks + 8 * q);
            Bq[ks] = __builtin_bit_cast(bf16x8, z); }
        const unsigned kofs = (unsigned)(g * 64 + 8 * q) * 2u;
        bf16x8 KA[16][2];
#pragma unroll
        for (int kt = 0; kt < 16; ++kt) { const unsigned ko = (unsigned)sel[16 * kt + c] * 512u + kofs;
            KA[kt][0] = *(const bf16x8*)((const char*)kvb + ko); KA[kt][1] = *(const bf16x8*)((const char*)kvb + ko + 64u); }
        f32x4 S[16];
#pragma unroll
        for (int kt = 0; kt < 16; ++kt) {
            f32x4 s = MFMA16(KA[kt][0], Bq[0], ((f32x4){0.f, 0.f, 0.f, 0.f}));
            s = MFMA16(KA[kt][1], Bq[1], s);
            const bool ok = kt < ntile;
#pragma unroll
            for (int e = 0; e < 4; ++e) s[e] = ok ? s[e] : -__builtin_inff();
            S[kt] = s;
        }
#define VLOAD(XX, u0, nu) do { _Pragma("unroll") for (int u_ = 0; u_ < nu; ++u_) { \
            const u32x2 s0_ = *(const LAS u32x2*)(sel + 32 * (u0 + u_) + 4 * q), s1_ = *(const LAS u32x2*)(sel + 32 * (u0 + u_) + 16 + 4 * q); \
            int sid_[8]; sid_[0] = s0_.x & 0xffff; sid_[1] = s0_.x >> 16; sid_[2] = s0_.y & 0xffff; sid_[3] = s0_.y >> 16; sid_[4] = s1_.x & 0xffff; sid_[5] = s1_.x >> 16; sid_[6] = s1_.y & 0xffff; sid_[7] = s1_.y >> 16; \
            _Pragma("unroll") for (int e_ = 0; e_ < 8; ++e_) XX[u_][e_] = *(const u32x2*)((const char*)kvb + ((unsigned)sid_[e_] * 512u + vofs)); } } while (0)
#define PVSTEP(XX, u0, nu) do { _Pragma("unroll") for (int u_ = 0; u_ < nu; ++u_) { u32x4 w0, w1, w2, w3; \
            w0.x = __builtin_amdgcn_perm(XX[u_][1].x, XX[u_][0].x, 0x05040100u); w0.y = __builtin_amdgcn_perm(XX[u_][3].x, XX[u_][2].x, 0x05040100u); w0.z = __builtin_amdgcn_perm(XX[u_][5].x, XX[u_][4].x, 0x05040100u); w0.w = __builtin_amdgcn_perm(XX[u_][7].x, XX[u_][6].x, 0x05040100u); \
            w1.x = __builtin_amdgcn_perm(XX[u_][1].x, XX[u_][0].x, 0x07060302u); w1.y = __builtin_amdgcn_perm(XX[u_][3].x, XX[u_][2].x, 0x07060302u); w1.z = __builtin_amdgcn_perm(XX[u_][5].x, XX[u_][4].x, 0x07060302u); w1.w = __builtin_amdgcn_perm(XX[u_][7].x, XX[u_][6].x, 0x07060302u); \
            w2.x = __builtin_amdgcn_perm(XX[u_][1].y, XX[u_][0].y, 0x05040100u); w2.y = __builtin_amdgcn_perm(XX[u_][3].y, XX[u_][2].y, 0x05040100u); w2.z = __builtin_amdgcn_perm(XX[u_][5].y, XX[u_][4].y, 0x05040100u); w2.w = __builtin_amdgcn_perm(XX[u_][7].y, XX[u_][6].y, 0x05040100u); \
            w3.x = __builtin_amdgcn_perm(XX[u_][1].y, XX[u_][0].y, 0x07060302u); w3.y = __builtin_amdgcn_perm(XX[u_][3].y, XX[u_][2].y, 0x07060302u); w3.z = __builtin_amdgcn_perm(XX[u_][5].y, XX[u_][4].y, 0x07060302u); w3.w = __builtin_amdgcn_perm(XX[u_][7].y, XX[u_][6].y, 0x07060302u); \
            O[0] = MFMA16(Pk[u0 + u_], __builtin_bit_cast(bf16x8, w0), O[0]); O[1] = MFMA16(Pk[u0 + u_], __builtin_bit_cast(bf16x8, w1), O[1]); \
            O[2] = MFMA16(Pk[u0 + u_], __builtin_bit_cast(bf16x8, w2), O[2]); O[3] = MFMA16(Pk[u0 + u_], __builtin_bit_cast(bf16x8, w3), O[3]); } } while (0)
        const unsigned vofs = (unsigned)(128 + g * 64 + 4 * c) * 2u;
        __builtin_amdgcn_sched_barrier(0);
        u32x2 X0[4][8]; VLOAD(X0, 0, 4);
        __builtin_amdgcn_sched_barrier(0);
        const float sc = 0.125f * 1.4426950408889634f;
        float mx = -3.0e38f;
#pragma unroll
        for (int kt = 0; kt < 16; ++kt)
#pragma unroll
            for (int e = 0; e < 4; ++e) mx = fmaxf(mx, S[kt][e]);
        mx = fmaxf(mx, __shfl_xor(mx, 16)); mx = fmaxf(mx, __shfl_xor(mx, 32));
        float sum = 0.f;
#pragma unroll
        for (int kt = 0; kt < 16; ++kt)
#pragma unroll
            for (int e = 0; e < 4; ++e) { const float pe = __builtin_amdgcn_exp2f((S[kt][e] - mx) * sc); S[kt][e] = pe; sum += pe; }
        sum += __shfl_xor(sum, 16); sum += __shfl_xor(sum, 32);
        const float inv = 1.0f / sum;
        bf16x8 Pk[8];
#pragma unroll
        for (int u = 0; u < 8; ++u) Pk[u] = pack_p(S[2 * u] * inv, S[2 * u + 1] * inv);
        __builtin_amdgcn_sched_barrier(0);
        u32x2 X1[2][8]; VLOAD(X1, 4, 2);
        __builtin_amdgcn_sched_barrier(0);
        f32x4 O[4];
#pragma unroll
        for (int dt = 0; dt < 4; ++dt) O[dt] = (f32x4){0.f, 0.f, 0.f, 0.f};
        PVSTEP(X0, 0, 4);
        __builtin_amdgcn_sched_barrier(0);
        u32x2 X2[2][8]; VLOAD(X2, 6, 2);
        __builtin_amdgcn_sched_barrier(0);
        PVSTEP(X1, 4, 2);
        PVSTEP(X2, 6, 2);
#undef VLOAD
#undef PVSTEP
        if (q == 0) {
#pragma unroll
            for (int hh = 0; hh < 4; ++hh) { u32x2 w; w.x = cvt_pk_bf16(O[0][hh], O[1][hh]); w.y = cvt_pk_bf16(O[2][hh], O[3][hh]);
                *(u32x2*)(Ao + (size_t)row * 512 + (4 * g + hh) * 64 + 4 * c) = w; }
        }
    }
}

__device__ __forceinline__ u32x2 pack8_fp8(const float (&v)[8]) {
    int a = __builtin_amdgcn_cvt_pk_fp8_f32(v[0], v[1], 0, false); a = __builtin_amdgcn_cvt_pk_fp8_f32(v[2], v[3], a, true);
    int b = __builtin_amdgcn_cvt_pk_fp8_f32(v[4], v[5], 0, false); b = __builtin_amdgcn_cvt_pk_fp8_f32(v[6], v[7], b, true);
    u32x2 r; r.x = (unsigned)a; r.y = (unsigned)b; return r;
}
__device__ __forceinline__ long mk64(unsigned lo, unsigned hi) { return (long)(((unsigned long long)hi << 32) | (unsigned long long)lo); }
__device__ __forceinline__ void sparse_attn_query8(const unsigned char* QA8, const unsigned char* kv8, bf16_t* Ao, int row, const LAS unsigned short* sel, int ntile, int lane) {
    const int c = lane & 15, q = lane >> 4;
#pragma unroll 1
    for (int g = 0; g < 2; ++g) {
        long Bq[2];
#pragma unroll
        for (int ks = 0; ks < 2; ++ks) { u32x2 z = (u32x2){0u, 0u};
            if (c < 4) z = *(const u32x2*)(QA8 + (size_t)row * 512 + (4 * g + c) * 64 + 16 * q + 8 * ks);
            Bq[ks] = mk64(z.x, z.y); }
        const unsigned kofs = (unsigned)(g * 64 + 16 * q), vofs = (unsigned)(128 + g * 64 + 4 * c);
        u32x4 KA[16];
#pragma unroll
        for (int kt = 0; kt < 16; ++kt) { const unsigned ko = (unsigned)sel[16 * kt + c] * 256u + kofs;
            KA[kt] = *(const u32x4*)(kv8 + ko); }
        unsigned XV[8][8];
#pragma unroll
        for (int u = 0; u < 8; ++u) {
            const u32x2 s0 = *(const LAS u32x2*)(sel + 32 * u + 4 * q), s1 = *(const LAS u32x2*)(sel + 32 * u + 16 + 4 * q);
            unsigned sid[8]; sid[0] = s0.x & 0xffffu; sid[1] = s0.x >> 16; sid[2] = s0.y & 0xffffu; sid[3] = s0.y >> 16; sid[4] = s1.x & 0xffffu; sid[5] = s1.x >> 16; sid[6] = s1.y & 0xffffu; sid[7] = s1.y >> 16;
#pragma unroll
            for (int e = 0; e < 8; ++e) XV[u][e] = *(const unsigned*)(kv8 + (sid[e] * 256u + vofs));
        }
        f32x4 S[16];
#pragma unroll
        for (int kt = 0; kt < 16; ++kt) {
            f32x4 s = __builtin_amdgcn_mfma_f32_16x16x32_fp8_fp8(mk64(KA[kt].x, KA[kt].y), Bq[0], ((f32x4){0.f, 0.f, 0.f, 0.f}), 0, 0, 0);
            s = __builtin_amdgcn_mfma_f32_16x16x32_fp8_fp8(mk64(KA[kt].z, KA[kt].w), Bq[1], s, 0, 0, 0);
            const bool ok = kt < ntile;
#pragma unroll
            for (int e = 0; e < 4; ++e) s[e] = ok ? s[e] : -__builtin_inff();
            S[kt] = s;
        }
        const float sc = 0.125f * 1.4426950408889634f;
        float mx = -3.0e38f;
#pragma unroll
        for (int kt = 0; kt < 16; ++kt)
#pragma unroll
            for (int e = 0; e < 4; ++e) mx = fmaxf(mx, S[kt][e]);
        mx = fmaxf(mx, __shfl_xor(mx, 16)); mx = fmaxf(mx, __shfl_xor(mx, 32));
        float sum = 0.f;
#pragma unroll
        for (int kt = 0; kt < 16; ++kt)
#pragma unroll
            for (int e = 0; e < 4; ++e) { const float pe = __builtin_amdgcn_exp2f((S[kt][e] - mx) * sc); S[kt][e] = pe; sum += pe; }
        sum += __shfl_xor(sum, 16); sum += __shfl_xor(sum, 32);
        const float inv = 1.0f / sum;
        f32x4 O[4];
#pragma unroll
        for (int dt = 0; dt < 4; ++dt) O[dt] = (f32x4){0.f, 0.f, 0.f, 0.f};
#pragma unroll
        for (int u = 0; u < 8; ++u) {
            int p0 = __builtin_amdgcn_cvt_pk_bf8_f32(S[2 * u][0], S[2 * u][1], 0, false); p0 = __builtin_amdgcn_cvt_pk_bf8_f32(S[2 * u][2], S[2 * u][3], p0, true);
            int p1 = __builtin_amdgcn_cvt_pk_bf8_f32(S[2 * u + 1][0], S[2 * u + 1][1], 0, false); p1 = __builtin_amdgcn_cvt_pk_bf8_f32(S[2 * u + 1][2], S[2 * u + 1][3], p1, true);
            const long Pk = mk64((unsigned)p0, (unsigned)p1);
            const unsigned a0 = __builtin_amdgcn_perm(XV[u][1], XV[u][0], 0x05010400u), b0 = __builtin_amdgcn_perm(XV[u][1], XV[u][0], 0x07030602u);
            const unsigned c0 = __builtin_amdgcn_perm(XV[u][3], XV[u][2], 0x05010400u), d0 = __builtin_amdgcn_perm(XV[u][3], XV[u][2], 0x07030602u);
            const unsigned a1 = __builtin_amdgcn_perm(XV[u][5], XV[u][4], 0x05010400u), b1 = __builtin_amdgcn_perm(XV[u][5], XV[u][4], 0x07030602u);
            const unsigned c1 = __builtin_amdgcn_perm(XV[u][7], XV[u][6], 0x05010400u), d1 = __builtin_amdgcn_perm(XV[u][7], XV[u][6], 0x07030602u);
            const long V0 = mk64(__builtin_amdgcn_perm(c0, a0, 0x05040100u), __builtin_amdgcn_perm(c1, a1, 0x05040100u));
            const long V1 = mk64(__builtin_amdgcn_perm(c0, a0, 0x07060302u), __builtin_amdgcn_perm(c1, a1, 0x07060302u));
            const long V2 = mk64(__builtin_amdgcn_perm(d0, b0, 0x05040100u), __builtin_amdgcn_perm(d1, b1, 0x05040100u));
            const long V3 = mk64(__builtin_amdgcn_perm(d0, b0, 0x07060302u), __builtin_amdgcn_perm(d1, b1, 0x07060302u));
            O[0] = __builtin_amdgcn_mfma_f32_16x16x32_bf8_fp8(Pk, V0, O[0], 0, 0, 0);
            O[1] = __builtin_amdgcn_mfma_f32_16x16x32_bf8_fp8(Pk, V1, O[1], 0, 0, 0);
            O[2] = __builtin_amdgcn_mfma_f32_16x16x32_bf8_fp8(Pk, V2, O[2], 0, 0, 0);
            O[3] = __builtin_amdgcn_mfma_f32_16x16x32_bf8_fp8(Pk, V3, O[3], 0, 0, 0);
        }
        float invh[4];
#pragma unroll
        for (int hh = 0; hh < 4; ++hh) invh[hh] = __shfl(inv, hh);
        if (q == 0) {
#pragma unroll
            for (int hh = 0; hh < 4; ++hh) { u32x2 w; w.x = cvt_pk_bf16(O[0][hh] * invh[hh], O[1][hh] * invh[hh]); w.y = cvt_pk_bf16(O[2][hh] * invh[hh], O[3][hh] * invh[hh]);
                *(u32x2*)(Ao + (size_t)row * 512 + (4 * g + hh) * 64 + 4 * c) = w; }
        }
    }
}

template <int NQ>
__device__ __forceinline__ void sparse_attn_lds(const unsigned char* QA8, const unsigned char* kv8, bf16_t* Ao, int qrow0, const LAS unsigned short* selb, LAS unsigned char* buf, int nch, int lane) {
    const int c = lane & 15, q = lane >> 4;
    long Bq[NQ][2][2];
#pragma unroll
    for (int qq = 0; qq < NQ; ++qq)
#pragma unroll
        for (int g = 0; g < 2; ++g)
#pragma unroll
            for (int ks = 0; ks < 2; ++ks) { u32x2 z = (u32x2){0u, 0u};
                if (c < 4) z = *(const u32x2*)(QA8 + (size_t)(qrow0 + qq) * 512 + (4 * g + c) * 64 + 16 * q + 8 * ks);
                Bq[qq][g][ks] = mk64(z.x, z.y); }
    const int nsteps = NQ * nch;
    asm volatile("s_waitcnt lgkmcnt(0)" ::: "memory");
#define DMA_CHUNK(qq_, u_) do { const LAS unsigned short* sp_ = selb + (qq_) * 256 + (u_) * 32; LAS unsigned char* db_ = buf + ((u_) & 1) * 8192; \
        _Pragma("unroll") for (int p = 0; p < 8; ++p) { const int r_ = 4 * p + q; const unsigned src_ = (unsigned)sp_[r_] * 256u + 16u * (unsigned)(c ^ (r_ & 15)); \
            __builtin_amdgcn_global_load_lds((const unsigned*)(kv8 + src_), (LAS unsigned*)(db_ + p * 1024), 16, 0, 0); } } while (0)
    DMA_CHUNK(0, 0);
    DMA_CHUNK(0, 1);
    const float sc = 0.125f * 1.4426950408889634f;
    int sidx = 0;
#pragma unroll
    for (int qq = 0; qq < NQ; ++qq) {
        float m0 = -3.0e38f, m1 = -3.0e38f, l0 = 0.f, l1 = 0.f;
        f32x4 O[2][4];
#pragma unroll
        for (int g = 0; g < 2; ++g)
#pragma unroll
            for (int dt = 0; dt < 4; ++dt) O[g][dt] = (f32x4){0.f, 0.f, 0.f, 0.f};
#pragma unroll 1
        for (int u = 0; u < nch; ++u, ++sidx) {
            if (sidx + 1 < nsteps) asm volatile("s_waitcnt vmcnt(8)" ::: "memory"); else asm volatile("s_waitcnt vmcnt(0)" ::: "memory");
            const LAS unsigned char* b_ = buf + (u & 1) * 8192;
#pragma unroll
            for (int g = 0; g < 2; ++g) {
                const unsigned kslot = (unsigned)(((4 * g + q) ^ c) * 16);
                const u32x4 ka0 = *(const LAS u32x4*)(b_ + c * 256 + kslot), ka1 = *(const LAS u32x4*)(b_ + (16 + c) * 256 + kslot);
                f32x4 s0 = __builtin_amdgcn_mfma_f32_16x16x32_fp8_fp8(mk64(ka0.x, ka0.y), Bq[qq][g][0], ((f32x4){0.f, 0.f, 0.f, 0.f}), 0, 0, 0);
                s0 = __builtin_amdgcn_mfma_f32_16x16x32_fp8_fp8(mk64(ka0.z, ka0.w), Bq[qq][g][1], s0, 0, 0, 0);
                f32x4 s1 = __builtin_amdgcn_mfma_f32_16x16x32_fp8_fp8(mk64(ka1.x, ka1.y), Bq[qq][g][0], ((f32x4){0.f, 0.f, 0.f, 0.f}), 0, 0, 0);
                s1 = __builtin_amdgcn_mfma_f32_16x16x32_fp8_fp8(mk64(ka1.z, ka1.w), Bq[qq][g][1], s1, 0, 0, 0);
                float cm = fmaxf(fmaxf(fmaxf(s0[0], s0[1]), fmaxf(s0[2], s0[3])), fmaxf(fmaxf(s1[0], s1[1]), fmaxf(s1[2], s1[3])));
                cm = fmaxf(cm, __shfl_xor(cm, 16)); cm = fmaxf(cm, __shfl_xor(cm, 32));
                const float mo = g ? m1 : m0, mn = fmaxf(mo, cm);
                const float al = __builtin_amdgcn_exp2f((mo - mn) * sc);
                float ls = 0.f;
#pragma unroll
                for (int e = 0; e < 4; ++e) { s0[e] = __builtin_amdgcn_exp2f((s0[e] - mn) * sc); s1[e] = __builtin_amdgcn_exp2f((s1[e] - mn) * sc); ls += s0[e] + s1[e]; }
                if (g) { m1 = mn; l1 = l1 * al + ls; } else { m0 = mn; l0 = l0 * al + ls; }
                float ah[4];
#pragma unroll
                for (int h = 0; h < 4; ++h) ah[h] = __int_as_float(__builtin_amdgcn_readlane(__float_as_int(al), h));
#pragma unroll
                for (int dt = 0; dt < 4; ++dt)
#pragma unroll
                    for (int h = 0; h < 4; ++h) O[g][dt][h] *= ah[h];
                int p0 = __builtin_amdgcn_cvt_pk_bf8_f32(s0[0], s0[1], 0, false); p0 = __builtin_amdgcn_cvt_pk_bf8_f32(s0[2], s0[3], p0, true);
                int p1 = __builtin_amdgcn_cvt_pk_bf8_f32(s1[0], s1[1], 0, false); p1 = __builtin_amdgcn_cvt_pk_bf8_f32(s1[2], s1[3], p1, true);
                const long Pk = mk64((unsigned)p0, (unsigned)p1);
                unsigned xv[8];
#pragma unroll
                for (int e = 0; e < 8; ++e) { const int r_ = (e < 4) ? 4 * q + e : 16 + 4 * q + (e - 4);
                    xv[e] = *(const LAS unsigned*)(b_ + r_ * 256 + 16 * ((8 + 4 * g + (c >> 2)) ^ (r_ & 15)) + 4 * (c & 3)); }
                const unsigned a0 = __builtin_amdgcn_perm(xv[1], xv[0], 0x05010400u), b0 = __builtin_amdgcn_perm(xv[1], xv[0], 0x07030602u);
                const unsigned c0 = __builtin_amdgcn_perm(xv[3], xv[2], 0x05010400u), d0 = __builtin_amdgcn_perm(xv[3], xv[2], 0x07030602u);
                const unsigned a1 = __builtin_amdgcn_perm(xv[5], xv[4], 0x05010400u), b1 = __builtin_amdgcn_perm(xv[5], xv[4], 0x07030602u);
                const unsigned c1 = __builtin_amdgcn_perm(xv[7], xv[6], 0x05010400u), d1 = __builtin_amdgcn_perm(xv[7], xv[6], 0x07030602u);
                O[g][0] = __builtin_amdgcn_mfma_f32_16x16x32_bf8_fp8(Pk, mk64(__builtin_amdgcn_perm(c0, a0, 0x05040100u), __builtin_amdgcn_perm(c1, a1, 0x05040100u)), O[g][0], 0, 0, 0);
                O[g][1] = __builtin_amdgcn_mfma_f32_16x16x32_bf8_fp8(Pk, mk64(__builtin_amdgcn_perm(c0, a0, 0x07060302u), __builtin_amdgcn_perm(c1, a1, 0x07060302u)), O[g][1], 0, 0, 0);
                O[g][2] = __builtin_amdgcn_mfma_f32_16x16x32_bf8_fp8(Pk, mk64(__builtin_amdgcn_perm(d0, b0, 0x05040100u), __builtin_amdgcn_perm(d1, b1, 0x05040100u)), O[g][2], 0, 0, 0);
                O[g][3] = __builtin_amdgcn_mfma_f32_16x16x32_bf8_fp8(Pk, mk64(__builtin_amdgcn_perm(d0, b0, 0x07060302u), __builtin_amdgcn_perm(d1, b1, 0x07060302u)), O[g][3], 0, 0, 0);
            }
            if (u == nch - 1) {
#pragma unroll
                for (int g = 0; g < 2; ++g) {
                    float lt = g ? l1 : l0; lt += __shfl_xor(lt, 16); lt += __shfl_xor(lt, 32);
                    const float inv = 1.0f / lt;
                    float ih[4];
#pragma unroll
                    for (int h = 0; h < 4; ++h) ih[h] = __int_as_float(__builtin_amdgcn_readlane(__float_as_int(inv), h));
                    if (q == 0) {
#pragma unroll
                        for (int h = 0; h < 4; ++h) { u32x2 w; w.x = cvt_pk_bf16(O[g][0][h] * ih[h], O[g][1][h] * ih[h]); w.y = cvt_pk_bf16(O[g][2][h] * ih[h], O[g][3][h] * ih[h]);
                            *(u32x2*)(Ao + (size_t)(qrow0 + qq) * 512 + (4 * g + h) * 64 + 4 * c) = w; }
                    }
                }
            }
            asm volatile("s_waitcnt lgkmcnt(0)" ::: "memory");
            if (sidx + 2 < nsteps) { int nq_ = qq, nu_ = u + 2; if (nu_ >= nch) { nu_ -= nch; nq_ += 1; } DMA_CHUNK(nq_, nu_); }
        }
    }
#undef DMA_CHUNK
}

__device__ __forceinline__ void scan_hist(const LAS unsigned* hq, int need, int lane, int& bin, int& above) {
    int sum = 0;
#pragma unroll
    for (int w = 0; w < 16; ++w) { const unsigned x = hq[16 * lane + w]; sum += (int)(x & 0xffffu) + (int)(x >> 16); }
    int suf = sum;
#pragma unroll
    for (int off = 1; off < 64; off <<= 1) { const int v = __shfl_down(suf, off); if (lane + off < 64) suf += v; }
    int nx = __shfl_down(suf, 1); if (lane == 63) nx = 0;
    const bool hit = (suf >= need) && (nx < need);
    const unsigned long long mk = __ballot(hit);
    const int L = mk ? (int)__builtin_ctzll(mk) : 0;
    const int aboveL = __shfl(nx, L);
    const unsigned xw = hq[16 * L + ((lane & 31) >> 1)];
    int cj = (lane & 1) ? (int)(xw >> 16) : (int)(xw & 0xffffu); if (lane >= 32) cj = 0;
    int suf2 = cj;
#pragma unroll
    for (int off = 1; off < 32; off <<= 1) { const int v = __shfl_down(suf2, off); if (lane + off < 64) suf2 += v; }
    int nx2 = __shfl_down(suf2, 1); if (lane == 63) nx2 = 0;
    const int need2 = need - aboveL;
    const bool hit2 = (lane < 32) && (suf2 >= need2) && (nx2 < need2);
    const unsigned long long mk2 = __ballot(hit2);
    const int J = mk2 ? (int)__builtin_ctzll(mk2) : 0;
    bin = 32 * L + J; above = aboveL + __shfl(nx2, J);
}

__device__ __forceinline__ void scan_hist1024(const LAS unsigned* hq, int need, int lane, int& bin, int& above, int& inbin) {
    int sum = 0;
#pragma unroll
    for (int w = 0; w < 8; ++w) { const unsigned x = hq[8 * lane + w]; sum += (int)(x & 0xffffu) + (int)(x >> 16); }
    int suf = sum;
#pragma unroll
    for (int off = 1; off < 64; off <<= 1) { const int v = __shfl_down(suf, off); if (lane + off < 64) suf += v; }
    int nx = __shfl_down(suf, 1); if (lane == 63) nx = 0;
    const bool hit = (suf >= need) && (nx < need);
    const unsigned long long mk = __ballot(hit);
    const int L = mk ? (int)__builtin_ctzll(mk) : 0;
    const int aboveL = __shfl(nx, L);
    const unsigned xw = hq[8 * L + ((lane & 15) >> 1)];
    int cj = (lane & 1) ? (int)(xw >> 16) : (int)(xw & 0xffffu); if (lane >= 16) cj = 0;
    int suf2 = cj;
#pragma unroll
    for (int off = 1; off < 16; off <<= 1) { const int v = __shfl_down(suf2, off); if (lane + off < 64) suf2 += v; }
    int nx2 = __shfl_down(suf2, 1); if (lane == 63) nx2 = 0;
    const int need2 = need - aboveL;
    const bool hit2 = (lane < 16) && (suf2 >= need2) && (nx2 < need2);
    const unsigned long long mk2 = __ballot(hit2);
    const int J = mk2 ? (int)__builtin_ctzll(mk2) : 0;
    bin = 16 * L + J; above = aboveL + __shfl(nx2, J); inbin = __shfl(cj, J);
}

__device__ __forceinline__ void radix_select4(const bf16_t* QI, const float* WI, const bf16_t* kib, int n, int qrow0, LAS unsigned* hist, LAS unsigned short* selb, int lane) {
    const int hf = lane >> 5, l31 = lane & 31;
    const unsigned lmask = (1u << l31) - 1u;
    bf16x8 A0, A1; float w0[8], w1[8];
    { const int r = l31, qq = 2 * ((r & 7) >> 2) + (r >> 4), hd = 4 * ((r >> 3) & 1) + (r & 3);
      const bf16_t* qp = QI + (size_t)(qrow0 + qq) * 256 + hd * 32 + 8 * hf;
      A0 = *(const bf16x8*)qp; A1 = *(const bf16x8*)(qp + 16);
      const float* wp0 = WI + (size_t)(qrow0 + 2 * hf) * 8;
#pragma unroll
      for (int e = 0; e < 8; ++e) { w0[e] = wp0[e]; w1[e] = wp0[8 + e]; } }
    unsigned pref0 = 0, pref1 = 0;
    int need0 = 256, need1 = 256;
#define SCORE_TILE(s0, k0v, k1v) do { const bf16_t* kp_ = kib + (size_t)((s0) + l31) * 32 + 8 * hf; \
        f32x16 ac_ = {0.f,0.f,0.f,0.f,0.f,0.f,0.f,0.f,0.f,0.f,0.f,0.f,0.f,0.f,0.f,0.f}; \
        ac_ = MFMA32(A0, *(const bf16x8*)kp_, ac_); ac_ = MFMA32(A1, *(const bf16x8*)(kp_ + 16), ac_); \
        float sa_ = 0.f, sb_ = 0.f; \
        _Pragma("unroll") for (int e_ = 0; e_ < 8; ++e_) { sa_ = fmaf(w0[e_], fmaxf(ac_[e_], 0.f), sa_); sb_ = fmaf(w1[e_], fmaxf(ac_[8 + e_], 0.f), sb_); } \
        const unsigned ua_ = __float_as_uint(sa_), ub_ = __float_as_uint(sb_); \
        k0v = (ua_ & 0x80000000u) ? ~ua_ : (ua_ | 0x80000000u); k1v = (ub_ & 0x80000000u) ? ~ub_ : (ub_ | 0x80000000u); } while (0)
#pragma unroll 1
    for (int pass = 0; pass < 3; ++pass) {
        { u32x4 z = (u32x4){0u, 0u, 0u, 0u};
#pragma unroll
          for (int i = 0; i < 16; ++i) *(LAS u32x4*)(hist + 4 * (lane + 64 * i)) = z; }
        const int shp = (pass == 0) ? 21 : (pass == 1 ? 10 : 0);
        const unsigned bmask = (pass == 2) ? 1023u : 2047u;
        const int shm = (pass == 0) ? 31 : (pass == 1 ? 21 : 10);
        for (int s0 = 0; s0 < n; s0 += 32) {
            unsigned k0, k1; SCORE_TILE(s0, k0, k1);
            const bool m0 = (pass == 0) || ((k0 >> shm) == pref0), m1 = (pass == 0) || ((k1 >> shm) == pref1);
            if (m0) { const unsigned bin = (k0 >> shp) & bmask; __hip_atomic_fetch_add(hist + (2 * hf) * 1024 + (bin >> 1), 1u << (16 * (bin & 1)), __ATOMIC_RELAXED, __HIP_MEMORY_SCOPE_WORKGROUP); }
            if (m1) { const unsigned bin = (k1 >> shp) & bmask; __hip_atomic_fetch_add(hist + (2 * hf + 1) * 1024 + (bin >> 1), 1u << (16 * (bin & 1)), __ATOMIC_RELAXED, __HIP_MEMORY_SCOPE_WORKGROUP); }
        }
        int bins[4], abv[4];
#pragma unroll
        for (int qq = 0; qq < 4; ++qq) {
            const int nd = __shfl((qq & 1) ? need1 : need0, (qq >> 1) * 32);
            scan_hist(hist + qq * 1024, nd, lane, bins[qq], abv[qq]);
        }
        const int b0 = hf ? bins[2] : bins[0], b1 = hf ? bins[3] : bins[1], a0 = hf ? abv[2] : abv[0], a1 = hf ? abv[3] : abv[1];
        if (pass == 0) { pref0 = (unsigned)b0; pref1 = (unsigned)b1; }
        else if (pass == 1) { pref0 = (pref0 << 11) | (unsigned)b0; pref1 = (pref1 << 11) | (unsigned)b1; }
        else { pref0 = (pref0 << 10) | (unsigned)b0; pref1 = (pref1 << 10) | (unsigned)b1; }
        need0 -= a0; need1 -= a1;
    }
    int cnt0 = 0, cnt1 = 0, tie0 = 0, tie1 = 0;
    for (int s0 = 0; s0 < n; s0 += 32) {
        unsigned k0, k1; SCORE_TILE(s0, k0, k1);
        {
            const bool eq = (k0 == pref0); const unsigned long long bt = __ballot(eq); const unsigned hb = hf ? (unsigned)(bt >> 32) : (unsigned)bt;
            const bool take = (k0 > pref0) || (eq && (tie0 + (int)__popc(hb & lmask) < need0)); tie0 += (int)__popc(hb);
            const unsigned long long bs = __ballot(take); const unsigned hs = hf ? (unsigned)(bs >> 32) : (unsigned)bs;
            const int pos = cnt0 + (int)__popc(hs & lmask); cnt0 += (int)__popc(hs);
            if (take && pos < 256) selb[(2 * hf) * 256 + pos] = (unsigned short)(s0 + l31);
        }
        {
            const bool eq = (k1 == pref1); const unsigned long long bt = __ballot(eq); const unsigned hb = hf ? (unsigned)(bt >> 32) : (unsigned)bt;
            const bool take = (k1 > pref1) || (eq && (tie1 + (int)__popc(hb & lmask) < need1)); tie1 += (int)__popc(hb);
            const unsigned long long bs = __ballot(take); const unsigned hs = hf ? (unsigned)(bs >> 32) : (unsigned)bs;
            const int pos = cnt1 + (int)__popc(hs & lmask); cnt1 += (int)__popc(hs);
            if (take && pos < 256) selb[(2 * hf + 1) * 256 + pos] = (unsigned short)(s0 + l31);
        }
    }
#undef SCORE_TILE
}

#define XB_TMO      128
#define XB_XCNT(j)  (256  + 64 * (j))
#define XB_XSUB(j)  (1280 + 64 * (j))
#define XB_XGEN(j)  (2304 + 64 * (j))
#define XB_TOP      3328
#define XB_TOPGEN   3392
#define XCD_BAR_WORDS 3456
#define XB_SPIN_CAP (1u << 18)

__device__ __forceinline__ unsigned xb_ld(unsigned* p)              { return __hip_atomic_load(p, __ATOMIC_RELAXED, __HIP_MEMORY_SCOPE_AGENT); }
__device__ __forceinline__ unsigned xb_add(unsigned* p, unsigned v) { return __hip_atomic_fetch_add(p, v, __ATOMIC_RELAXED, __HIP_MEMORY_SCOPE_AGENT); }
__device__ __forceinline__ unsigned xb_xcc_id() { return (unsigned)__builtin_amdgcn_s_getreg((3 << 11) | 20) & 0xFu; }
#define XB_SPIN(cond, bar) do { unsigned _sp = 0; while (cond) { __builtin_amdgcn_s_sleep(1); \
    if ((++_sp & 255u) == 0u) { if (xb_ld(&(bar)[XB_TMO])) break; if (_sp > XB_SPIN_CAP) { atomicAdd(&(bar)[XB_TMO], 1u); break; } } } } while (0)

struct XcdBarrier {
    unsigned* bar; unsigned x;
    volatile unsigned* st;
};

__device__ __forceinline__ XcdBarrier xcd_barrier_post(unsigned* bar, volatile unsigned* st) {
    XcdBarrier b; b.bar = bar; b.x = xb_xcc_id(); b.st = st;
    if (threadIdx.x == 0) (void)xb_add(&bar[XB_XCNT(b.x)], 1u);
    return b;
}
__device__ __forceinline__ void xcd_barrier_complete(unsigned* bar, unsigned x, unsigned& nloc, unsigned& nx) {
    const unsigned G = gridDim.x * gridDim.y * gridDim.z;
    unsigned sum, cnt, mine, sp = 0u;
    for (;;) {
        sum = 0u; cnt = 0u; mine = 0u;
#pragma unroll
        for (unsigned j = 0; j < 16; ++j) { const unsigned c = xb_ld(&bar[XB_XCNT(j)]); sum += c; cnt += (c > 0u) ? 1u : 0u; mine = (j == x) ? c : mine; }
        if (sum == G) break;
        __builtin_amdgcn_s_sleep(1);
        if ((++sp & 255u) == 0u) { if (xb_ld(&bar[XB_TMO])) break; if (sp > XB_SPIN_CAP) { atomicAdd(&bar[XB_TMO], 1u); break; } }
    }
    nloc = mine > 0u ? mine : 1u; nx = cnt > 0u ? cnt : 1u;
}

__device__ __forceinline__ void xcd_barrier(const XcdBarrier& b) {
    asm volatile("s_waitcnt vmcnt(0)" ::: "memory");
    __syncthreads();
    if (threadIdx.x == 0) {
        unsigned* bar = b.bar;
        __builtin_amdgcn_s_waitcnt(0);
        unsigned nloc = b.st[0], nx = b.st[1];
        if (nloc == 0u) { xcd_barrier_complete(bar, b.x, nloc, nx); b.st[0] = nloc; b.st[1] = nx; }
        const unsigned old = xb_add(&bar[XB_XSUB(b.x)], 1u);
        const unsigned gen = old / nloc;
        if (old + 1u == (gen + 1u) * nloc) {
            __builtin_amdgcn_fence(__ATOMIC_RELEASE, "agent");
            asm volatile("s_waitcnt vmcnt(0)" ::: "memory");
            const unsigned og = xb_add(&bar[XB_TOP], 1u);
            const unsigned tg = og / nx;
            if (og + 1u == (tg + 1u) * nx) xb_add(&bar[XB_TOPGEN], 1u);
            else XB_SPIN(xb_ld(&bar[XB_TOPGEN]) == tg, bar);
            __builtin_amdgcn_fence(__ATOMIC_ACQUIRE, "agent");
            xb_add(&bar[XB_XGEN(b.x)], 1u);
            asm volatile("s_waitcnt vmcnt(0)" ::: "memory");
        } else {
            XB_SPIN(xb_ld(&bar[XB_XGEN(b.x)]) == gen, bar);
            __builtin_amdgcn_fence(__ATOMIC_ACQUIRE, "agent");
            asm volatile("s_waitcnt vmcnt(0)" ::: "memory");
        }
    }
    __syncthreads();
}

__global__ void __launch_bounds__(512, 2) fwd_kernel(Args a) {
    extern __shared__ __attribute__((aligned(16))) unsigned char lds_raw[];
    LAS unsigned char* lds = (LAS unsigned char*)lds_raw;
    cg::grid_group grid = cg::this_grid();
    const int tid = threadIdx.x, lane = tid & 63, wave = __builtin_amdgcn_readfirstlane(tid >> 6);
    const int G = gridDim.x, gw = blockIdx.x * 8 + wave, NGW = G * 8;
    unsigned char* ws = a.ws; float* out = a.out;
    const float *x_prompt = a.in[0], *x_sample = a.in[1], *mem_prompt = a.in[2], *cache_a_k = a.in[3], *cache_a_v = a.in[4], *cache_idx_k = a.in[5], *cache_pool = a.in[6],
                *cache_mem_k = a.in[7], *cache_mem_v = a.in[8], *g_mix = a.in[9], *w_in = a.in[10], *g_qa = a.in[11], *g_ka = a.in[12], *g_kidx = a.in[13], *g_qm = a.in[14],
                *g_mem = a.in[15], *w_mem_kv = a.in[16], *g_km = a.in[17], *w_pool = a.in[18], *s_pool = a.in[19], *w_oa = a.in[20], *w_ob = a.in[21], *w_om = a.in[22],
                *w_out = a.in[23], *g_ffn = a.in[24], *w_gate = a.in[25], *w_up = a.in[26], *w_down = a.in[27];
    bf16_t *WIN = (bf16_t*)(ws + WS_WIN), *WMEM = (bf16_t*)(ws + WS_WMEM), *WPOOL = (bf16_t*)(ws + WS_WPOOL), *WOA = (bf16_t*)(ws + WS_WOA), *WOB = (bf16_t*)(ws + WS_WOB),
           *WOM = (bf16_t*)(ws + WS_WOM), *WOUT = (bf16_t*)(ws + WS_WOUT), *WGU = (bf16_t*)(ws + WS_WGU), *WDN = (bf16_t*)(ws + WS_WDN), *MEMN = (bf16_t*)(ws + WS_MEMN),
           *KVMEM = (bf16_t*)(ws + WS_KVMEM), *MKB = (bf16_t*)(ws + WS_MKB), *MVT = (bf16_t*)(ws + WS_MVT), *KVS = (bf16_t*)(ws + WS_KVS), *KIS = (bf16_t*)(ws + WS_KIS),
           *KI = (bf16_t*)(ws + WS_KI), *H = (bf16_t*)(ws + WS_H), *QA = (bf16_t*)(ws + WS_QA), *KV = (bf16_t*)(ws + WS_KV), *QI = (bf16_t*)(ws + WS_QI),
           *UB = (bf16_t*)(ws + WS_UB), *QM = (bf16_t*)(ws + WS_QM), *PP = (bf16_t*)(ws + WS_PP), *GT = (bf16_t*)(ws + WS_G);
    float *WI = (float*)(ws + WS_WI), *KW32 = (float*)(ws + WS_KW32);
    unsigned char *KV8 = ws + WS_KV8, *QA8 = ws + WS_QA8, *KVS8 = ws + WS_KVS8;
    bf16_t* QL = (bf16_t*)(ws + WS_QL); bf16_t* WDN2 = (bf16_t*)(ws + WS_WDN2); float* PART = (float*)(ws + WS_QA);
    unsigned* ctl = (unsigned*)(ws + WS_CTL);
    bf16_t *ABR = H, *MBR = H + (size_t)MT * 512;
    float* Y = out + O_Y;
    volatile unsigned* xst = ctl + 8192 + 2 * blockIdx.x;
    __syncthreads();
    const XcdBarrier xbar = xcd_barrier_post(ctl + 4096, xst);

    {
        LAS float* scr = (LAS float*)(lds + wave * 16384);
        for (int it = gw; it < 8704; it += NGW) {
            int r = it; const float* W; int K, N, destN; bf16_t* WT; int kind;
            if (r < 2688) { kind = 0; W = w_in; K = 1024; N = 5160; destN = NIN; WT = WIN; }
            else if ((r -= 2688) < 512) { kind = 1; W = w_mem_kv; K = 1024; N = 1024; destN = 1024; WT = WMEM; }
            else if ((r -= 512) < 256) { kind = 1; W = w_oa; K = 512; N = 1024; destN = 1024; WT = WOA; }
            else if ((r -= 256) < 256) { kind = 1; W = w_ob; K = 512; N = 1024; destN = 1024; WT = WOB; }
            else if ((r -= 256) < 256) { kind = 1; W = w_om; K = 512; N = 1024; destN = 1024; WT = WOM; }
            else if ((r -= 256) < 512) { kind = 1; W = w_out; K = 1024; N = 1024; destN = 1024; WT = WOUT; }
            else if ((r -= 512) < 2816) { kind = 2; W = w_gate; K = 1024; N = DFF; destN = NGU; WT = WGU; }
            else { r -= 2816; kind = 1; W = w_down; K = DFF; N = 1024; destN = 1024; WT = WDN; }
            const int nblk = destN / 32, kb = r / nblk, nb = r % nblk, n = nb * 32 + (lane & 31);
            int col = n;
            if (kind == 0) col = map_in(n);
            else if (kind == 2) { const int j = n >> 8, rr = n & 255; if (rr >= 128) W = w_up; col = 128 * j + (rr & 127); }
            transpose_item(W, N, K, WT, kb * 64, nb * 32, col, scr, lane, kind == 2 ? g_ffn : nullptr);
        }
        for (int it = gw; it < 1408; it += NGW) {
            const int ks = it >> 7, rr = it & 127, kb = rr >> 5, nb = rr & 31;
            transpose_item(w_down + (size_t)ks * 256 * 1024, 1024, 256, WDN2 + (size_t)ks * 1024 * 256, kb * 64, nb * 32, nb * 32 + (lane & 31), scr, lane);
        }
        for (int idx = gw * 64 + lane; idx < 512 * 256; idx += NGW * 64) {
            const int n = idx >> 8, kk = idx & 255, g = n >> 7, e = n & 127;
            const float v = ((kk >> 7) == (g & 1)) ? w_pool[(size_t)(g * 128 + (kk & 127)) * 128 + e] : 0.f;
            WPOOL[idx] = (bf16_t)(cvt_pk_bf16(v, 0.f) & 0xffffu);
        }
        {
            f32x4 gg[4];
#pragma unroll
            for (int j = 0; j < 4; ++j) gg[j] = ((const f32x4*)g_mix)[lane + 64 * j];
            f32x4 va[4], vb[4], na[4], nb[4];
            int r = gw;
#define XROW(rr_) ((rr_) < MP ? x_prompt + (size_t)(rr_) * 1024 : x_sample + (size_t)((rr_) - MP) * 1024)
            if (r < MT) { const float* xa = XROW(r); const int r1 = r + NGW; const float* xb = r1 < MT ? XROW(r1) : xa;
#pragma unroll
                for (int j = 0; j < 4; ++j) { va[j] = ((const f32x4*)xa)[lane + 64 * j]; vb[j] = ((const f32x4*)xb)[lane + 64 * j]; } }
            for (; r < MT; r += 2 * NGW) {
                const int r1 = r + NGW; const bool has1 = r1 < MT;
                const int rn = r + 2 * NGW;
                if (rn < MT) { const float* xa = XROW(rn); const int rn1 = rn + NGW; const float* xb = rn1 < MT ? XROW(rn1) : xa;
#pragma unroll
                    for (int j = 0; j < 4; ++j) { na[j] = ((const f32x4*)xa)[lane + 64 * j]; nb[j] = ((const f32x4*)xb)[lane + 64 * j]; } }
                float sa = 0.f, sb = 0.f;
#pragma unroll
                for (int j = 0; j < 4; ++j) { sa += (va[j].x * va[j].x + va[j].y * va[j].y) + (va[j].z * va[j].z + va[j].w * va[j].w); sb += (vb[j].x * vb[j].x + vb[j].y * vb[j].y) + (vb[j].z * vb[j].z + vb[j].w * vb[j].w); }
                const float ra = rsqrtf(wave_sum(sa) * (1.f / 1024.f) + EPS), rb = rsqrtf(wave_sum(sb) * (1.f / 1024.f) + EPS);
#pragma unroll
                for (int j = 0; j < 4; ++j) {
                    u32x2 w; w.x = cvt_pk_bf16(va[j].x * ra * gg[j].x, va[j].y * ra * gg[j].y); w.y = cvt_pk_bf16(va[j].z * ra * gg[j].z, va[j].w * ra * gg[j].w);
                    *(u32x2*)(H + (size_t)r * 1024 + 4 * lane + 256 * j) = w;
                    if (has1) { u32x2 w2; w2.x = cvt_pk_bf16(vb[j].x * rb * gg[j].x, vb[j].y * rb * gg[j].y); w2.y = cvt_pk_bf16(vb[j].z * rb * gg[j].z, vb[j].w * rb * gg[j].w);
                        *(u32x2*)(H + (size_t)r1 * 1024 + 4 * lane + 256 * j) = w2; } }
#pragma unroll
                for (int j = 0; j < 4; ++j) { va[j] = na[j]; vb[j] = nb[j]; }
            }
#undef XROW
        }
        for (int r = gw; r < 2048; r += NGW) rms_row_1024(mem_prompt + (size_t)r * 1024, g_mem, MEMN + (size_t)r * 1024, lane);
        for (int r = gw; r < 16 * 1024; r += NGW) {
            const int b = r >> 10, s = r & 1023;
            const float* src = (lane < 32) ? cache_a_k + (size_t)r * 128 + 4 * lane : cache_a_v + (size_t)r * 128 + 4 * (lane - 32);
            const f32x4 v = *(const f32x4*)src; u32x2 w; w.x = cvt_pk_bf16(v.x, v.y); w.y = cvt_pk_bf16(v.z, v.w);
            { int f8 = __builtin_amdgcn_cvt_pk_fp8_f32(v.x, v.y, 0, false); f8 = __builtin_amdgcn_cvt_pk_fp8_f32(v.z, v.w, f8, true);
              *(unsigned*)(KVS8 + (size_t)(b * SKEYS + s) * 256 + 4 * lane) = (unsigned)f8; }
        }
        for (int idx = gw * 64 + lane; idx < 16 * 1024 * 16; idx += NGW * 64) {
            const int r = idx >> 4, c2 = idx & 15, b = r >> 10, s = r & 1023;
            const float v0 = cache_idx_k[(size_t)r * 32 + 2 * c2], v1 = cache_idx_k[(size_t)r * 32 + 2 * c2 + 1];
            *(unsigned*)(KIS + (size_t)(b * SKEYS + s) * 32 + 2 * c2) = cvt_pk_bf16(v0, v1);
        }
        for (int i0 = gw * 64 + lane; i0 < 16 * 256 * 256; i0 += 4 * NGW * 64) {
            f32x4 va[2]; float v0[4], v1[4];
#pragma unroll
            for (int j = 0; j < 4; ++j) { const int idx = i0 + j * NGW * 64; const bool ok = idx < 16 * 256 * 256; v0[j] = ok ? cache_mem_k[(size_t)idx * 2] : 0.f; v1[j] = ok ? cache_mem_k[(size_t)idx * 2 + 1] : 0.f; }
#pragma unroll
            for (int j = 0; j < 4; ++j) { const int idx = i0 + j * NGW * 64; if (idx < 16 * 256 * 256) *(unsigned*)(MKB + (size_t)2048 * 512 + (size_t)idx * 2) = cvt_pk_bf16(v0[j], v1[j]); }
            (void)va;
        }
        for (int it = gw; it < 16 * 8 * 8; it += NGW) {
            const int b = it >> 6, kb = (it >> 3) & 7, hb = it & 7;
            float tv[32];
#pragma unroll
            for (int k = 0; k < 32; ++k) tv[k] = cache_mem_v[((size_t)(b * 256 + kb * 32 + k)) * 512 + hb * 64 + lane];
#pragma unroll
            for (int k = 0; k < 32; ++k) scr[k * 65 + lane] = tv[k];
            asm volatile("s_waitcnt lgkmcnt(0)" ::: "memory");
#pragma unroll 4
            for (int h = 0; h < 64; h += 4) { const int hh = h + (lane >> 4), k2 = (lane & 15) * 2;
                const float a0 = scr[k2 * 65 + hh], a1 = scr[(k2 + 1) * 65 + hh];
                *(unsigned*)(MVT + ((size_t)(8 + b) * 512 + hb * 64 + hh) * 256 + kb * 32 + k2) = cvt_pk_bf16(a0, a1); }
            asm volatile("s_waitcnt lgkmcnt(0)" ::: "memory");
        }
    }
    grid.sync();

    {
        pg8::StaticOrder S; S.init(MT, NIN, G, (int)blockIdx.x);
        pg8::Gemm g{H, WIN, MT, NIN, 1024, 1024, 1024, 0, nullptr, nullptr, nullptr, nullptr, 0};
        Epi<EP_INPROJ> E; E.p = EpiArgs{}; E.p.QA = QA; E.p.KV = KV; E.p.QI = QI; E.p.UB = UB; E.p.QM = QM; E.p.G = GT; E.p.KW32 = KW32;
        pg8::gemm_phase(lds, g, S, E);
        pg8::StaticOrder S2; S2.init(2048, 1024, G, (int)blockIdx.x >= G - 32 ? (int)blockIdx.x - (G - 32) : (1 << 20));
        pg8::Gemm g2{MEMN, WMEM, 2048, 1024, 1024, 1024, 1024, 0, nullptr, nullptr, nullptr, nullptr, 0};
        Epi<EP_BF16> E2; E2.p = EpiArgs{}; E2.p.O = KVMEM; E2.p.ldc = 1024; E2.p.cs = nullptr;
        pg8::gemm_phase(lds, g2, S2, E2);
    }
    xcd_barrier(xbar);

    float inv64[8], inv16q[4];
    {
        const int j8h = lane & 7;
#pragma unroll
        for (int e = 0; e < 8; ++e) inv64[e] = powf(10000.0f, -(float)(8 * (j8h & 3) + e) * (1.0f / 32.0f));
#pragma unroll
        for (int e = 0; e < 4; ++e) inv16q[e] = powf(10000.0f, -(float)(4 * (j8h & 3) + e) * (1.0f / 16.0f));
    }
    const float inv16k = powf(10000.0f, -(float)(lane & 15) * (1.0f / 16.0f));
    float gqa_[8], gka_[8], gqm_[8];
#pragma unroll
    for (int e = 0; e < 8; ++e) { gqa_[e] = g_qa[8 * (lane & 7) + e]; gka_[e] = g_ka[8 * (lane & 7) + e]; gqm_[e] = g_qm[8 * (lane & 15) + e]; }
    const float gkidx_ = g_kidx[lane & 31];
    for (int row = gw; row < MT; row += NGW) {
        const bool samp = row >= MP; const int rs = row - MP;
        int b, t, pos; if (!samp) { b = row >> 13; t = row & 8191; pos = t; } else { b = rs >> 6; t = rs & 63; pos = 1024 + t; }
        const float fpos = (float)pos;
        const int j8 = lane & 7;
        const u32x4 qa_raw = *(const u32x4*)(QA + (size_t)row * 512 + 8 * lane);
        u32x4 kv_raw = (u32x4){0u, 0u, 0u, 0u}; if (lane < 32) kv_raw = *(const u32x4*)(KV + (size_t)row * 256 + 8 * lane);
        const u32x2 qi_raw = *(const u32x2*)(QI + (size_t)row * 256 + 4 * lane);
        const float kw_x = KW32[(size_t)row * 64 + lane];
        const u32x4 qm_raw = *(const u32x4*)(QM + (size_t)row * 512 + 8 * lane);
        const int pw_ = 2 << (lane >> 4);
        u32x4 ubr[16];
#pragma unroll
        for (int k = 0; k < 16; ++k) { ubr[k] = (u32x4){0u, 0u, 0u, 0u}; if (k < pw_ && t - k >= 0) ubr[k] = *(const u32x4*)(UB + (size_t)(row - k) * 512 + 8 * lane); }
        float c64[8], s64[8];
#pragma unroll
        for (int e = 0; e < 8; ++e) sincos_red(fpos * inv64[e], s64[e], c64[e]);
        {
            float v[8]; unpack8(qa_raw, v);
            float ss = 0.f;
#pragma unroll
            for (int e = 0; e < 8; ++e) ss += v[e] * v[e];
            ss += __shfl_xor(ss, 1); ss += __shfl_xor(ss, 2); ss += __shfl_xor(ss, 4);
            const float rstd = rsqrtf(ss * (1.f / 64.f) + EPS);
            float o[8];
#pragma unroll
            for (int e = 0; e < 8; ++e) { v[e] = v[e] * rstd * gqa_[e]; }
#pragma unroll
            for (int e = 0; e < 8; ++e) { const float pv = __shfl_xor(v[e], 4); o[e] = (j8 < 4) ? v[e] * c64[e] - pv * s64[e] : v[e] * c64[e] + pv * s64[e]; }
            *(u32x2*)(QA8 + (size_t)row * 512 + 8 * lane) = pack8_fp8(o);
        }
        {
            float v[8]; unpack8(kv_raw, v);
            float ss = 0.f;
#pragma unroll
            for (int e = 0; e < 8; ++e) ss += v[e] * v[e];
            ss += __shfl_xor(ss, 1); ss += __shfl_xor(ss, 2); ss += __shfl_xor(ss, 4);
            const float rstd = rsqrtf(ss * (1.f / 64.f) + EPS);
            float kn[8], o[8];
#pragma unroll
            for (int e = 0; e < 8; ++e) kn[e] = v[e] * rstd * gka_[e];
#pragma unroll
            for (int e = 0; e < 8; ++e) { const float pv = __shfl_xor(kn[e], 4); o[e] = (j8 < 4) ? kn[e] * c64[e] - pv * s64[e] : kn[e] * c64[e] + pv * s64[e]; }
            float* ok = samp ? out + O_AKS + (size_t)rs * 128 : out + O_AKP + (size_t)row * 128;
            float* ov = samp ? out + O_AVS + (size_t)rs * 128 : out + O_AVP + (size_t)row * 128;
            if (lane < 16) {
                { const u32x2 w8 = pack8_fp8(o); *(u32x2*)(KV8 + (size_t)row * 256 + 8 * lane) = w8; if (samp) *(u32x2*)(KVS8 + (size_t)(b * SKEYS + 1024 + t) * 256 + 8 * lane) = w8; }
                *(f32x4*)(ok + 8 * lane) = (f32x4){o[0], o[1], o[2], o[3]}; *(f32x4*)(ok + 8 * lane + 4) = (f32x4){o[4], o[5], o[6], o[7]};
            } else if (lane < 32) {
                { const u32x2 w8 = pack8_fp8(v); *(u32x2*)(KV8 + (size_t)row * 256 + 8 * lane) = w8; if (samp) *(u32x2*)(KVS8 + (size_t)(b * SKEYS + 1024 + t) * 256 + 8 * lane) = w8; }
                *(f32x4*)(ov + 8 * (lane - 16)) = (f32x4){v[0], v[1], v[2], v[3]}; *(f32x4*)(ov + 8 * (lane - 16) + 4) = (f32x4){v[4], v[5], v[6], v[7]};
            }
        }
        {
            const u32x2 qv = qi_raw;
            float v[4] = {bflo(qv.x), bfhi(qv.x), bflo(qv.y), bfhi(qv.y)}, o[4];
#pragma unroll
            for (int e = 0; e < 4; ++e) { float sn, cs; sincos_red(fpos * inv16q[e], sn, cs);
                const float pv = __shfl_xor(v[e], 4); o[e] = (j8 < 4) ? v[e] * cs - pv * sn : v[e] * cs + pv * sn; }
            u32x2 w; w.x = cvt_pk_bf16(o[0], o[1]); w.y = cvt_pk_bf16(o[2], o[3]);
            *(u32x2*)(QI + (size_t)row * 256 + 4 * lane) = w;
            {
                const float wh = __shfl(kw_x, 32 + (lane >> 3)) * (0.0625f * 0.5f);
                float ql[4] = {wh * bflo(w.x), wh * bfhi(w.x), wh * bflo(w.y), wh * bfhi(w.y)};
#pragma unroll
                for (int off = 8; off < 64; off <<= 1) {
#pragma unroll
                    for (int e = 0; e < 4; ++e) ql[e] += __shfl_xor(ql[e], off); }
                if (lane < 8) { u32x2 wq; wq.x = cvt_pk_bf16(ql[0], ql[1]); wq.y = cvt_pk_bf16(ql[2], ql[3]); *(u32x2*)(QL + (size_t)row * 32 + 4 * lane) = wq; }
            }
        }
        {
            const float x = kw_x;
            float ss = (lane < 32) ? x * x : 0.f;
            ss += __shfl_xor(ss, 1); ss += __shfl_xor(ss, 2); ss += __shfl_xor(ss, 4); ss += __shfl_xor(ss, 8); ss += __shfl_xor(ss, 16);
            const float rstd = rsqrtf(ss * (1.f / 32.f) + EPS);
            const float yv = x * rstd * gkidx_;
            float sn, cs; sincos_red(fpos * inv16k, sn, cs);
            const float pv = __shfl_xor(yv, 16);
            const float o = ((lane & 31) < 16) ? yv * cs - pv * sn : yv * cs + pv * sn;
            const unsigned ob = cvt_pk_bf16(o, 0.f) & 0xffffu;
            if (lane < 32) {
                KI[(size_t)row * 32 + lane] = (bf16_t)ob;
                if (samp) { KIS[(size_t)(b * SKEYS + 1024 + t) * 32 + lane] = (bf16_t)ob; out[O_IKS + (size_t)rs * 32 + lane] = o; }
                else out[O_IKP + (size_t)row * 32 + lane] = o;
            } else if (lane < 40) WI[(size_t)row * 8 + (lane - 32)] = x * 0.0625f;
        }
        {
            float v[8]; unpack8(qm_raw, v);
            float ss = 0.f;
#pragma unroll
            for (int e = 0; e < 8; ++e) ss += v[e] * v[e];
            ss += __shfl_xor(ss, 1); ss += __shfl_xor(ss, 2); ss += __shfl_xor(ss, 4); ss += __shfl_xor(ss, 8);
            const float rstd = rsqrtf(ss * (1.f / 128.f) + EPS);
#pragma unroll
            for (int e = 0; e < 8; ++e) v[e] = v[e] * rstd * gqm_[e];
            *(u32x4*)(QM + (size_t)row * 512 + 8 * lane) = pack8(v);
        }
        {
            const int c0 = 8 * lane, gi = lane >> 4, w = 2 << gi;
            float u[8], sum[8];
            unpack8(ubr[0], u);
#pragma unroll
            for (int e = 0; e < 8; ++e) sum[e] = u[e];
#pragma unroll
            for (int k = 1; k < 16; ++k) { float x[8]; unpack8(ubr[k], x);
#pragma unroll
                for (int e = 0; e < 8; ++e) sum[e] += x[e]; }
            if (samp && t < 15) {
                for (int k = 1; k < 16; ++k) {
                    const int tt = t - k;
                    if (k < w && tt < 0) { const float* cp = cache_pool + (size_t)(b * 15 + 15 + tt) * 512 + c0; const f32x4 x0 = *(const f32x4*)cp, x1 = *(const f32x4*)(cp + 4);
                        sum[0] += x0.x; sum[1] += x0.y; sum[2] += x0.z; sum[3] += x0.w; sum[4] += x1.x; sum[5] += x1.y; sum[6] += x1.z; sum[7] += x1.w; }
                }
            }
            const int cnt = samp ? w : (w < t + 1 ? w : t + 1);
            const float ic = 1.0f / (float)cnt;
            float o[8];
#pragma unroll
            for (int e = 0; e < 8; ++e) o[e] = sum[e] * ic - u[e];
            *(u32x4*)(PP + (size_t)row * 512 + c0) = pack8(o);
            float* po = nullptr;
            if (!samp && t >= 8177) po = out + O_PLP + (size_t)(b * 15 + (t - 8177)) * 512 + c0;
            if (samp && t >= 49) po = out + O_PLS + (size_t)(b * 15 + (t - 49)) * 512 + c0;
            if (po) { *(f32x4*)po = (f32x4){u[0], u[1], u[2], u[3]}; *(f32x4*)(po + 4) = (f32x4){u[4], u[5], u[6], u[7]}; }
        }
    }
    for (int r = gw; r < 2048; r += NGW) {
        float v[8]; unpack8(*(const u32x4*)(KVMEM + (size_t)r * 1024 + 8 * lane), v);
        float ss = 0.f;
#pragma unroll
        for (int e = 0; e < 8; ++e) ss += v[e] * v[e];
        ss += __shfl_xor(ss, 1); ss += __shfl_xor(ss, 2); ss += __shfl_xor(ss, 4); ss += __shfl_xor(ss, 8);
        const float rstd = rsqrtf(ss * (1.f / 128.f) + EPS);
#pragma unroll
        for (int e = 0; e < 8; ++e) v[e] = v[e] * rstd * g_km[8 * (lane & 15) + e];
        *(u32x4*)(MKB + (size_t)r * 512 + 8 * lane) = pack8(v);
        float* mk = out + O_MKP + (size_t)r * 512 + 8 * lane;
        *(f32x4*)mk = (f32x4){v[0], v[1], v[2], v[3]}; *(f32x4*)(mk + 4) = (f32x4){v[4], v[5], v[6], v[7]};
        float x[8]; const u32x4 xr = *(const u32x4*)(KVMEM + (size_t)r * 1024 + 512 + 8 * lane); unpack8(xr, x);
        float* mv = out + O_MVP + (size_t)r * 512 + 8 * lane;
        *(f32x4*)mv = (f32x4){x[0], x[1], x[2], x[3]}; *(f32x4*)(mv + 4) = (f32x4){x[4], x[5], x[6], x[7]};
        const int b = r >> 8, key = r & 255; const unsigned xs[4] = {xr.x, xr.y, xr.z, xr.w};
#pragma unroll
        for (int e = 0; e < 8; ++e) MVT[((size_t)b * 512 + 8 * lane + e) * 256 + key] = (bf16_t)((e & 1) ? (xs[e >> 1] >> 16) : (xs[e >> 1] & 0xffffu));
    }
    xcd_barrier(xbar);

    {
        pg8::StaticOrder S; S.init(MT, 512, G, (int)blockIdx.x);
        pg8::Gemm g{PP, WPOOL, MT, 512, 256, 512, 256, 256, nullptr, nullptr, nullptr, nullptr, 0};
        Epi<EP_BF16> E; E.p = EpiArgs{}; E.p.O = UB; E.p.ldc = 512; E.p.cs = s_pool;
        pg8::gemm_phase(lds, g, S, E);
    }
    {
        LAS unsigned* hist = (LAS unsigned*)(lds + wave * 20480);
        LAS unsigned short* selb = (LAS unsigned short*)(lds + wave * 20480);
        LAS unsigned* candk = (LAS unsigned*)(lds + wave * 20480 + 4096);
        LAS unsigned short* candi = (LAS unsigned short*)(lds + wave * 20480 + 6144);
        LAS unsigned char* wbuf = lds + wave * 20480 + 4096;
        const int hf = lane >> 5, l31 = lane & 31;
        const unsigned lmask = (1u << l31) - 1u;
        const int myq = (int)(__builtin_amdgcn_s_getreg((3 << 11) | 20) & 7u);
#pragma unroll 1
        for (int kq = 0; kq < 8; ++kq) {
        const int qb = (myq + kq) & 7;
        for (;;) {
            int item = 0; if (lane == 0) item = (int)atomicAdd(ctl + 64 + 64 * qb, 1u);
            item = __builtin_amdgcn_readfirstlane(item);
            if (item >= 1040) break;
            int n, qrow0; const bf16_t *kib, *kvb; const unsigned char* kv8;
            if (item < 1024) { const int c = 127 - (item >> 3), sg = item & 7;
                n = 64 * (c + 1); qrow0 = qb * 8192 + c * 64 + sg * 8; kib = KI + (size_t)qb * 8192 * 32; kvb = KV + (size_t)qb * 8192 * 256; kv8 = KV8 + (size_t)qb * 8192 * 256; }
            else { const int j = item - 1024, sb = 2 * qb + (j >> 3), sg = j & 7;
                n = SKEYS; qrow0 = MP + sb * 64 + sg * 8; kib = KIS + (size_t)sb * SKEYS * 32; kvb = KVS + (size_t)sb * SKEYS * 256; kv8 = KVS8 + (size_t)sb * SKEYS * 256; }
            const int ntile = (n < 256 ? n : 256) >> 4;
            bool fast = false;
            if (n <= 256) {
                for (int i = lane; i < 2048; i += 64) selb[i] = (unsigned short)(i & 255);
                fast = true;
            } else {
                bf16x8 A00, A01, A10, A11; float wa[8], wb[8], wc_[8], wd[8];
                { const int r = l31, qq = 2 * ((r & 7) >> 2) + (r >> 4), hd = 4 * ((r >> 3) & 1) + (r & 3);
                  const bf16_t* qp = QI + (size_t)(qrow0 + qq) * 256 + hd * 32 + 8 * hf;
                  A00 = *(const bf16x8*)qp; A01 = *(const bf16x8*)(qp + 16); A10 = *(const bf16x8*)(qp + 4 * 256); A11 = *(const bf16x8*)(qp + 4 * 256 + 16);
                  const float* wp0 = WI + (size_t)(qrow0 + 2 * hf) * 8;
#pragma unroll
                  for (int e = 0; e < 8; ++e) { wa[e] = 0.5f * wp0[e]; wb[e] = 0.5f * wp0[8 + e]; wc_[e] = 0.5f * wp0[32 + e]; wd[e] = 0.5f * wp0[40 + e]; } }
                bf16x8 AL0, AL1;
                { u32x4 z0 = (u32x4){0u, 0u, 0u, 0u}, z1 = z0;
                  if (l31 < 8) { const int rg = l31 & 3, hr = l31 >> 2, qq = rg < 2 ? 2 * hr + rg : 4 + 2 * hr + (rg - 2);
                      const bf16_t* lp = QL + (size_t)(qrow0 + qq) * 32 + 8 * hf; z0 = *(const u32x4*)lp; z1 = *(const u32x4*)(lp + 16); }
                  AL0 = __builtin_bit_cast(bf16x8, z0); AL1 = __builtin_bit_cast(bf16x8, z1); }
#define SCORE8(b0_, b1_, sa_, sb_, sc_, sd_) do { \
                    f32x16 ac_ = {0.f,0.f,0.f,0.f,0.f,0.f,0.f,0.f,0.f,0.f,0.f,0.f,0.f,0.f,0.f,0.f}, ad_ = ac_; \
                    f32x16 al_ = ac_; \
                    ac_ = MFMA32(A00, b0_, ac_); ad_ = MFMA32(A10, b0_, ad_); al_ = MFMA32(AL0, b0_, al_); ac_ = MFMA32(A01, b1_, ac_); ad_ = MFMA32(A11, b1_, ad_); al_ = MFMA32(AL1, b1_, al_); \
                    sa_ = al_[0]; sb_ = al_[1]; sc_ = al_[2]; sd_ = al_[3];     \
                    _Pragma("unroll") for (int e_ = 0; e_ < 8; ++e_) { sa_ = fmaf(wa[e_], fabsf(ac_[e_]), sa_); sb_ = fmaf(wb[e_], fabsf(ac_[8 + e_]), sb_); \
                                                                      sc_ = fmaf(wc_[e_], fabsf(ad_[e_]), sc_); sd_ = fmaf(wd[e_], fabsf(ad_[8 + e_]), sd_); } } while (0)
#define KLOAD(s_, r0_, r1_) do { const bf16_t* kp_ = kib + (size_t)((s_) + l31) * 32 + 8 * hf; r0_ = *(const bf16x8*)kp_; r1_ = *(const bf16x8*)(kp_ + 16); } while (0)
#define BINOF(s_, lo_, sc_) ((int)fminf(fmaxf(((s_) - (lo_)) * (sc_), 0.f), 1023.f))
                float lo0, lo1, lo2, lo3, bs0, bs1, bs2, bs3;
                {
                    bf16x8 b0, b1, c0, c1; KLOAD(0, b0, b1); KLOAD(32, c0, c1);
                    float s0, s1, s2, s3, t0, t1, t2, t3; SCORE8(b0, b1, s0, s1, s2, s3); SCORE8(c0, c1, t0, t1, t2, t3);
                    float mn0 = fminf(s0, t0), mn1 = fminf(s1, t1), mn2 = fminf(s2, t2), mn3 = fminf(s3, t3);
                    float mx0 = fmaxf(s0, t0), mx1 = fmaxf(s1, t1), mx2 = fmaxf(s2, t2), mx3 = fmaxf(s3, t3);
#pragma unroll
                    for (int o = 1; o < 32; o <<= 1) {
                        mn0 = fminf(mn0, __shfl_xor(mn0, o)); mn1 = fminf(mn1, __shfl_xor(mn1, o)); mn2 = fminf(mn2, __shfl_xor(mn2, o)); mn3 = fminf(mn3, __shfl_xor(mn3, o));
                        mx0 = fmaxf(mx0, __shfl_xor(mx0, o)); mx1 = fmaxf(mx1, __shfl_xor(mx1, o)); mx2 = fmaxf(mx2, __shfl_xor(mx2, o)); mx3 = fmaxf(mx3, __shfl_xor(mx3, o)); }
                    const float r0 = mx0 - mn0, r1 = mx1 - mn1, r2 = mx2 - mn2, r3 = mx3 - mn3;
                    lo0 = mn0 - 0.5f * r0; lo1 = mn1 - 0.5f * r1; lo2 = mn2 - 0.5f * r2; lo3 = mn3 - 0.5f * r3;
                    bs0 = r0 > 0.f ? 511.f / r0 : 0.f; bs1 = r1 > 0.f ? 511.f / r1 : 0.f; bs2 = r2 > 0.f ? 511.f / r2 : 0.f; bs3 = r3 > 0.f ? 511.f / r3 : 0.f;
                }
                { u32x4 z = (u32x4){0u, 0u, 0u, 0u};
#pragma unroll
                  for (int i = 0; i < 16; ++i) *(LAS u32x4*)(hist + 4 * (lane + 64 * i)) = z; }
                {
                    bf16x8 b0, b1; KLOAD(0, b0, b1);
                    for (int s0 = 0; s0 < n; s0 += 32) {
                        bf16x8 nb0, nb1; KLOAD((s0 + 32 < n) ? s0 + 32 : s0, nb0, nb1);
                        float s0_, s1_, s2_, s3_; SCORE8(b0, b1, s0_, s1_, s2_, s3_);
                        const int i0 = BINOF(s0_, lo0, bs0), i1 = BINOF(s1_, lo1, bs1), i2 = BINOF(s2_, lo2, bs2), i3 = BINOF(s3_, lo3, bs3);
                        __hip_atomic_fetch_add(hist + (2 * hf) * 512 + (i0 >> 1), 1u << (16 * (i0 & 1)), __ATOMIC_RELAXED, __HIP_MEMORY_SCOPE_WORKGROUP);
                        __hip_atomic_fetch_add(hist + (2 * hf + 1) * 512 + (i1 >> 1), 1u << (16 * (i1 & 1)), __ATOMIC_RELAXED, __HIP_MEMORY_SCOPE_WORKGROUP);
                        __hip_atomic_fetch_add(hist + (4 + 2 * hf) * 512 + (i2 >> 1), 1u << (16 * (i2 & 1)), __ATOMIC_RELAXED, __HIP_MEMORY_SCOPE_WORKGROUP);
                        __hip_atomic_fetch_add(hist + (5 + 2 * hf) * 512 + (i3 >> 1), 1u << (16 * (i3 & 1)), __ATOMIC_RELAXED, __HIP_MEMORY_SCOPE_WORKGROUP);
                        b0 = nb0; b1 = nb1;
                    }
                }
                int bins[8], abv[8], inb[8]; int worst = 0;
#pragma unroll
                for (int qq = 0; qq < 8; ++qq) { scan_hist1024(hist + qq * 512, 256, lane, bins[qq], abv[qq], inb[qq]); worst = inb[qq] > worst ? inb[qq] : worst; }
                fast = (worst <= 64);
                if (fast) {
                    const int B0 = hf ? bins[2] : bins[0], B1 = hf ? bins[3] : bins[1], B2 = hf ? bins[6] : bins[4], B3 = hf ? bins[7] : bins[5];
                    int c0 = 0, c1 = 0, c2 = 0, c3 = 0, d0 = 0, d1 = 0, d2 = 0, d3 = 0;
                    bf16x8 b0, b1; KLOAD(0, b0, b1);
                    for (int s0 = 0; s0 < n; s0 += 32) {
                        bf16x8 nb0, nb1; KLOAD((s0 + 32 < n) ? s0 + 32 : s0, nb0, nb1);
                        float s0_, s1_, s2_, s3_; SCORE8(b0, b1, s0_, s1_, s2_, s3_);
#define SELSTEP(sv_, lo_, bs_, Bq_, cq_, dq_, slot_) do { const int bi_ = BINOF(sv_, lo_, bs_); const bool tk_ = bi_ > Bq_, cd_ = bi_ == Bq_; \
                            const unsigned long long m1_ = __ballot(tk_), m2_ = __ballot(cd_); const unsigned h1_ = hf ? (unsigned)(m1_ >> 32) : (unsigned)m1_, h2_ = hf ? (unsigned)(m2_ >> 32) : (unsigned)m2_; \
                            const int p1_ = cq_ + (int)__popc(h1_ & lmask), p2_ = dq_ + (int)__popc(h2_ & lmask); cq_ += (int)__popc(h1_); dq_ += (int)__popc(h2_); \
                            if (tk_ && p1_ < 256) selb[(slot_) * 256 + p1_] = (unsigned short)(s0 + l31); \
                            if (cd_ && p2_ < 64) { const unsigned u_ = __float_as_uint(sv_); candk[(slot_) * 64 + p2_] = (u_ & 0x80000000u) ? ~u_ : (u_ | 0x80000000u); candi[(slot_) * 64 + p2_] = (unsigned short)(s0 + l31); } } while (0)
                        SELSTEP(s0_, lo0, bs0, B0, c0, d0, 2 * hf);
                        SELSTEP(s1_, lo1, bs1, B1, c1, d1, 2 * hf + 1);
                        SELSTEP(s2_, lo2, bs2, B2, c2, d2, 4 + 2 * hf);
                        SELSTEP(s3_, lo3, bs3, B3, c3, d3, 5 + 2 * hf);
#undef SELSTEP
                        b0 = nb0; b1 = nb1;
                    }
#pragma unroll
                    for (int qq = 0; qq < 8; ++qq) {
                        const int m = inb[qq], r = 256 - abv[qq];
                        const unsigned k = (lane < m) ? candk[qq * 64 + lane] : 0u; const int ix = (lane < m) ? (int)candi[qq * 64 + lane] : 0;
                        int rank = 0;
                        for (int j = 0; j < m; ++j) { const unsigned kj = (unsigned)__shfl((int)k, j); const int ij = __shfl(ix, j); rank += ((kj > k) || (kj == k && ij < ix)) ? 1 : 0; }
                        const bool tk = (lane < m) && (rank < r);
                        const unsigned long long mm = __ballot(tk);
                        const int pos = abv[qq] + (int)__popcll(mm & ((1ull << lane) - 1ull));
                        if (tk && pos < 256) selb[qq * 256 + pos] = (unsigned short)ix;
                    }
                }
#undef SCORE8
#undef KLOAD
#undef BINOF
            }
            {
                const int ngrp = fast ? 1 : 2, ncall = fast ? 2 : 1;
#pragma unroll 1
                for (int grp = 0; grp < ngrp; ++grp) {
                    if (!fast) radix_select4(QI, WI, kib, n, qrow0 + 4 * grp, hist, selb, lane);
#pragma unroll 1
                    for (int hq = 0; hq < ncall; ++hq) sparse_attn_lds<4>(QA8, kv8, ABR, qrow0 + 4 * grp + 4 * hq, selb + 4 * hq * 256, wbuf, ntile >> 1, lane);
                }
            }
        }
        }
    }
    for (;;) {
        int it0 = 0; if (lane == 0) it0 = (int)atomicAdd(ctl + 32, 4u);
        it0 = __builtin_amdgcn_readfirstlane(it0);
        if (it0 >= (MT / 16) * 4) break;
#pragma unroll 1
        for (int j = 0; j < 4; ++j) { const int it = it0 + j; const int h = it & 3, r0 = (it >> 2) * 16;
            const int bb = r0 < MP ? (r0 >> 13) : 8 + ((r0 - MP) >> 6);
            mem_attn_item(QM, MKB + (size_t)bb * 256 * 512, MVT + ((size_t)bb * 512 + h * 128) * 256, MBR, r0, h, lane); }
    }
    xcd_barrier(xbar);
    {
        pg8::ChainOrder3 S; S.base.init(MT, 1024, G, (int)blockIdx.x);
        pg8::Gemm g{ABR, WOA, MT, 1024, 512, 512, 512, 0, UB, MBR, WOB, WOM, 0};
        Epi<EP_CHAIN> E; E.p = EpiArgs{}; E.p.G = GT;
        pg8::gemm_phase(lds, g, S, E);
    }
    xcd_barrier(xbar);
    {
        pg8::StaticOrder S; S.init(MT, 1024, G, (int)blockIdx.x);
        pg8::Gemm g{GT, WOUT, MT, 1024, 1024, 3072, 1024, 0, nullptr, nullptr, nullptr, nullptr, 0};
        Epi<EP_WOUT> E; E.p = EpiArgs{}; E.p.Y = Y; E.p.xp = x_prompt; E.p.xs = x_sample; E.p.XG = H; E.p.SS = KW32; E.p.gf = g_ffn;
        pg8::gemm_phase(lds, g, S, E);
    }
    xcd_barrier(xbar);
    {
        pg8::StaticOrder S; S.init(MT, NGU, G, (int)blockIdx.x);
        pg8::Gemm g{H, WGU, MT, NGU, 1024, 1024, 1024, 0, nullptr, nullptr, nullptr, nullptr, 0};
        Epi<EP_UP> E; E.p = EpiArgs{}; E.p.HID = GT; E.p.SS = KW32;
        pg8::gemm_phase(lds, g, S, E);
    }
    xcd_barrier(xbar);
    {
        pg8::StaticOrder S; S.init(MP, 1024, G, (int)blockIdx.x);
        pg8::Gemm g{GT, WDN, MP, 1024, DFF, DFF, DFF, 0, nullptr, nullptr, nullptr, nullptr, 0};
        Epi<EP_DOWN> E; E.p = EpiArgs{}; E.p.Y = Y; E.p.XG = H;
        pg8::gemm_phase(lds, g, S, E);
        pg8::StaticOrder S2; S2.init(MS, 11 * 1024, G, (int)blockIdx.x);
        pg8::Gemm g2{GT + (size_t)MP * DFF, WDN2, MS, 11 * 1024, 256, DFF, 256, 256, nullptr, nullptr, nullptr, nullptr, 2};
        Epi<EP_DOWN_PART> E2; E2.p = EpiArgs{}; E2.p.Y = PART;
        pg8::gemm_phase(lds, g2, S2, E2);
    }
    xcd_barrier(xbar);
    for (int i = (gw * 64 + lane) * 4; i < MS * 1024; i += NGW * 64 * 4) {
        const int r = i >> 10, cidx = i & 1023;
        const u32x2 xb = *(const u32x2*)(H + (size_t)(MP + r) * 1024 + cidx);
        f32x4 acc4 = (f32x4){bflo(xb.x), bfhi(xb.x), bflo(xb.y), bfhi(xb.y)};
#pragma unroll
        for (int ks = 0; ks < 11; ++ks) acc4 = acc4 + *(const f32x4*)(PART + ((size_t)ks * 1024 + r) * 1024 + cidx);
        *(f32x4*)(Y + (size_t)(MP + r) * 1024 + cidx) = acc4;
    }
}

extern "C" void kernel_launch(void* const* d_in, const int* in_sizes, int n_in, void* d_out, int out_size, void* d_ws, size_t ws_size, hipStream_t stream) {
    static int grid = 0;
    if (grid == 0) {
        if (n_in != 28 || ws_size < WS_END) { fprintf(stderr, "kernel_launch: unexpected inputs (n_in %d, ws %zu)\n", n_in, ws_size); grid = -1; return; }
        int dev = 0, cus = 0, per_cu = 0;
        (void)hipGetDevice(&dev);
        (void)hipDeviceGetAttribute(&cus, hipDeviceAttributeMultiprocessorCount, dev);
        (void)hipFuncSetAttribute((const void*)fwd_kernel, hipFuncAttributeMaxDynamicSharedMemorySize, LDS_BYTES);
        (void)hipOccupancyMaxActiveBlocksPerMultiprocessor(&per_cu, (const void*)fwd_kernel, 512, LDS_BYTES);
        if (per_cu < 1) per_cu = 1;
        grid = cus * per_cu;
    }
    if (grid < 0) return;
    (void)hipMemsetAsync((char*)d_ws + WS_CTL, 0, 65536, stream);
    Args a{};
    for (int i = 0; i < 28; ++i) a.in[i] = (const float*)d_in[i];
    a.out = (float*)d_out; a.ws = (unsigned char*)d_ws;
    void* args[] = {&a};
    hipError_t e = hipLaunchCooperativeKernel((const void*)fwd_kernel, dim3(grid), dim3(512), args, LDS_BYTES, stream);
    if (e != hipSuccess) fprintf(stderr, "cooperative launch failed: %s (grid %d)\n", hipGetErrorString(e), grid);
}
```

```cpp
#include <hip/hip_runtime.h>
#include <hip/hip_cooperative_groups.h>
#include <cstdint>
#include <cstdio>
namespace cg = cooperative_groups;

#define LAS __attribute__((address_space(3)))
typedef unsigned short bf16_t;
typedef short bf16x8 __attribute__((ext_vector_type(8)));
typedef float f32x4 __attribute__((ext_vector_type(4)));
typedef float f32x16 __attribute__((ext_vector_type(16)));
typedef unsigned u32x4 __attribute__((ext_vector_type(4)));
typedef unsigned u32x2 __attribute__((ext_vector_type(2)));

constexpr int MP = 65536, MS = 1024, MT = MP + MS;
constexpr int DM = 1024, NIN = 5376, DFF = 2816, NGU = 2 * DFF;
constexpr int SKEYS = 1088;
constexpr float EPS = 1e-6f;

constexpr size_t O_Y = 0, O_AKP = 68157440, O_AVP = 76546048, O_IKP = 84934656, O_PLP = 87031808, O_MKP = 87093248, O_MVP = 88141824,
                 O_AKS = 89190400, O_AVS = 89321472, O_IKS = 89452544, O_PLS = 89485312;

constexpr size_t MiB = 1u << 20;
constexpr size_t WS_CTL = 0;
constexpr size_t WS_WIN = 1 * MiB;
constexpr size_t WS_WMEM = 12 * MiB;
constexpr size_t WS_WPOOL = 14 * MiB;
constexpr size_t WS_WOA = 15 * MiB, WS_WOB = 16 * MiB, WS_WOM = 17 * MiB;
constexpr size_t WS_WOUT = 18 * MiB;
constexpr size_t WS_WGU = 20 * MiB;
constexpr size_t WS_WDN = 31 * MiB;
constexpr size_t WS_MEMN = 37 * MiB;
constexpr size_t WS_KVMEM = 41 * MiB;
constexpr size_t WS_MKB = 45 * MiB;
constexpr size_t WS_MVT = 51 * MiB;
constexpr size_t WS_KVS = 57 * MiB;
constexpr size_t WS_KIS = 66 * MiB;
constexpr size_t WS_KI = 68 * MiB;
constexpr size_t WS_WI = 73 * MiB;
constexpr size_t WS_KW32 = 76 * MiB;
constexpr size_t WS_H = 93 * MiB;
constexpr size_t WS_QA = 223 * MiB;
constexpr size_t WS_KV = 288 * MiB;
constexpr size_t WS_QI = 321 * MiB;
constexpr size_t WS_UB = 354 * MiB;
constexpr size_t WS_QM = 419 * MiB;
constexpr size_t WS_PP = 484 * MiB;
constexpr size_t WS_G = 549 * MiB;
constexpr size_t WS_KV8 = 940 * MiB;
constexpr size_t WS_QA8 = 958 * MiB;
constexpr size_t WS_KVS8 = 991 * MiB;
constexpr size_t WS_QL = 996 * MiB;
constexpr size_t WS_WDN2 = 1001 * MiB;
constexpr size_t WS_END = 1007 * MiB;

constexpr int LDS_BYTES = 163840;

namespace pg8 {
constexpr int BM = 256, BK = 64, HALF = 128, HTB = HALF * BK * 2, NXCD = 8, WGM = 4;
__device__ __forceinline__ void stage_rc(int b, int& R, int& C) { const int st = b / 1024, sb = b % 1024, swz = sb ^ (((sb >> 9) & 1) << 5); R = (st >> 1) * 16 + swz / 64; C = (st & 1) * 32 + (swz % 64) / 2; }
__device__ __forceinline__ int lds_byte(int r, int c) { const int st = (r >> 4) * 2 + (c >> 5), rr = r & 15, cc = c & 31, ob = rr * 64 + cc * 2; return st * 1024 + (ob ^ (((ob >> 9) & 1) << 5)); }
__device__ __forceinline__ int perm32(int rho) { const int n = rho >> 4, i = rho & 15; return 8 * (i >> 2) + 4 * n + (i & 3); }
struct Unit { int pm, pn, sub; };
struct Gemm { const bf16_t* A; const bf16_t* Bt; int M, N, K, lda, ldb, a_pn_off; const bf16_t *A1, *A2, *B1, *B2; int a_pn_shift; };
struct StaticOrder {
    int nM, nN, nwg, G, c;
    __device__ void init(int M, int N, int G_, int c_) { nM = M / BM; nN = N / BM; nwg = nM * nN; G = G_; c = c_; }
    __device__ bool next(int i, Unit& u) const {
        const long L = (long)i * G + c; if (L >= nwg) return false;
        int wgid = (int)L; { const int q = nwg / NXCD, r = nwg % NXCD, xcd = wgid % NXCD, off = wgid / NXCD; wgid = (xcd < r ? xcd * (q + 1) : r * (q + 1) + (xcd - r) * q) + off; }
        const int nig = WGM * nN, gid = wgid / nig, fm = gid * WGM, gsz = (nM - fm) < WGM ? (nM - fm) : WGM;
        u.pm = fm + ((wgid % nig) % gsz); u.pn = (wgid % nig) / gsz; u.sub = 0; return true;
    }
};
struct ChainOrder3 {
    StaticOrder base;
    __device__ bool next(int i, Unit& u) const { if (!base.next(i / 3, u)) return false; u.sub = i % 3; return true; }
};
__device__ __forceinline__ unsigned cvt_pk_bf16(float lo, float hi) { unsigned r; asm volatile("v_cvt_pk_bf16_f32 %0, %1, %2" : "=v"(r) : "v"(lo), "v"(hi)); return r; }

template <class Epi, class Sched>
__device__ __forceinline__ void gemm_phase(LAS unsigned char* lds, const Gemm g, const Sched& S, const Epi& E) {
    const int tid = threadIdx.x, wid = __builtin_amdgcn_readfirstlane(tid >> 6), lane = tid & 63, wr = wid >> 2, wc = wid & 3, fr = lane & 15, fq = lane >> 4;
    const int K = g.K, nt = K / BK;
    unsigned voffA[2], voffB[2];
#pragma unroll
    for (int i = 0; i < 2; ++i) { int R, C; stage_rc(tid * 16 + i * 8192, R, C); const int Rb = (R & ~31) + perm32(R & 31);
        voffA[i] = (unsigned)(R * g.lda + C) * 2u; voffB[i] = (unsigned)(Rb * g.ldb + C) * 2u; }
    const size_t kstep = (size_t)(BK * 2);
    const size_t hstepA = (size_t)HALF * g.lda * 2, hstepB = (size_t)HALF * g.ldb * 2;
    const size_t tstepA = 2 * hstepA, tstepB = 2 * hstepB;
    const unsigned ldsw = (unsigned)wid * 1024u;
    const int aoff = lds_byte(wr * 64 + fr, fq * 8), boff = lds_byte(wc * 32 + fr, fq * 8);
#define PG8_SA(b, h) (((b) * 2 + (h)) * HTB)
#define PG8_SB(b, h) ((4 + (b) * 2 + (h)) * HTB)
#define PG8_STAGE(bufoff, gbase, voff) do { _Pragma("unroll") for (int _i = 0; _i < 2; ++_i) \
        __builtin_amdgcn_global_load_lds((const unsigned*)((const char*)(gbase) + (voff)[_i]), (LAS unsigned*)(lds + (bufoff) + ldsw + _i * 8192), 16, 0, 0); } while (0)
#define PG8_LDA(dst, b, h) do { _Pragma("unroll") for (int m = 0; m < 4; ++m) _Pragma("unroll") for (int k = 0; k < 2; ++k) dst[m][k] = *(const LAS bf16x8*)(lds + PG8_SA(b, h) + aoff + m * 2048 + k * 1024); } while (0)
#define PG8_LDB(dst, b, h) do { _Pragma("unroll") for (int n = 0; n < 2; ++n) _Pragma("unroll") for (int k = 0; k < 2; ++k) dst[n][k] = *(const LAS bf16x8*)(lds + PG8_SB(b, h) + boff + n * 2048 + k * 1024); } while (0)
#define PG8_MMA(ai, bj, At, Bt) do { __builtin_amdgcn_s_setprio(1); _Pragma("unroll") for (int m = 0; m < 4; ++m) _Pragma("unroll") for (int n = 0; n < 2; ++n) _Pragma("unroll") for (int k = 0; k < 2; ++k) \
        acc[ai][bj][m][n] = __builtin_amdgcn_mfma_f32_16x16x32_bf16(Bt[n][k], At[m][k], acc[ai][bj][m][n], 0, 0, 0); __builtin_amdgcn_s_setprio(0); } while (0)
#define PG8_WAIT_V(n) asm volatile("s_waitcnt vmcnt(" #n ")" ::: "memory")
#define PG8_WAIT_L(n) asm volatile("s_waitcnt lgkmcnt(" #n ")" ::: "memory")
#define PG8_BAR __builtin_amdgcn_s_barrier()
#define PG8_SCHED __builtin_amdgcn_sched_barrier(0)
    Unit cur, nxt; int ui = 0;
    if (!S.next(0, cur)) return;
    f32x4 acc[2][2][4][2];
#pragma unroll
    for (int a = 0; a < 2; ++a)
#pragma unroll
        for (int b = 0; b < 2; ++b)
#pragma unroll
            for (int m = 0; m < 4; ++m)
#pragma unroll
                for (int n = 0; n < 2; ++n) acc[a][b][m][n] = (f32x4){0.f, 0.f, 0.f, 0.f};
    bf16x8 At[4][2], B0[2][2], B1[2][2];
#define PG8_ABASE(u_) ((const char*)((u_).sub == 0 ? g.A : ((u_).sub == 1 ? g.A1 : g.A2)) + (size_t)(u_).pm * tstepA + (size_t)((u_).pn >> g.a_pn_shift) * g.a_pn_off * 2)
#define PG8_BBASE(u_) ((const char*)((u_).sub == 0 ? g.Bt : ((u_).sub == 1 ? g.B1 : g.B2)) + (size_t)(u_).pn * tstepB)
    const char* cA = PG8_ABASE(cur); const char* cB = PG8_BBASE(cur);
    PG8_STAGE(PG8_SB(0, 0), cB, voffB); PG8_STAGE(PG8_SB(0, 1), cB + hstepB, voffB); PG8_STAGE(PG8_SA(0, 0), cA, voffA); PG8_STAGE(PG8_SA(0, 1), cA + hstepA, voffA);
    if (wr == 1) PG8_BAR;
    PG8_WAIT_V(2); PG8_BAR;
    PG8_STAGE(PG8_SB(1, 0), cB + kstep, voffB); PG8_STAGE(PG8_SA(1, 0), cA + kstep, voffA); PG8_STAGE(PG8_SB(1, 1), cB + hstepB + kstep, voffB);
    PG8_WAIT_V(6); PG8_BAR;
    for (;;) {
        const bool has_next = S.next(ui + 1, nxt);
        const char* nA = has_next ? PG8_ABASE(nxt) : cA; const char* nB = has_next ? PG8_BBASE(nxt) : cB;
        for (int t = 0; t < nt; t += 2) {
            const bool last = (t == nt - 2);
            const char* a1 = cA + (size_t)(t + 1) * kstep;
            const char* a2 = last ? nA : cA + (size_t)(t + 2) * kstep; const char* b2 = last ? nB : cB + (size_t)(t + 2) * kstep;
            const char* a3 = a2 + kstep; const char* b3 = b2 + kstep;
            PG8_LDB(B0, 0, 0); PG8_LDB(B1, 0, 1); PG8_SCHED; PG8_LDA(At, 0, 0); PG8_STAGE(PG8_SA(1, 1), a1 + hstepA, voffA);
            PG8_WAIT_V(8); PG8_WAIT_L(0); PG8_BAR; PG8_MMA(0, 0, At, B0); PG8_MMA(0, 1, At, B1); PG8_BAR; PG8_SCHED;
            PG8_LDA(At, 0, 1); PG8_STAGE(PG8_SB(0, 0), b2, voffB); PG8_STAGE(PG8_SB(0, 1), b2 + hstepB, voffB); PG8_STAGE(PG8_SA(0, 0), a2, voffA);
            PG8_WAIT_V(8); PG8_WAIT_L(0); PG8_BAR; PG8_MMA(1, 0, At, B0); PG8_MMA(1, 1, At, B1); PG8_BAR; PG8_SCHED;
            PG8_LDB(B0, 1, 0); PG8_LDB(B1, 1, 1); PG8_SCHED; PG8_LDA(At, 1, 0); PG8_STAGE(PG8_SA(0, 1), a2 + hstepA, voffA);
            PG8_WAIT_V(8); PG8_WAIT_L(0); PG8_BAR; PG8_MMA(0, 0, At, B0); PG8_MMA(0, 1, At, B1); PG8_BAR; PG8_SCHED;
            PG8_LDA(At, 1, 1); PG8_STAGE(PG8_SB(1, 0), b3, voffB); PG8_STAGE(PG8_SB(1, 1), b3 + hstepB, voffB); PG8_STAGE(PG8_SA(1, 0), a3, voffA);
            PG8_WAIT_V(8); PG8_WAIT_L(0); PG8_BAR; PG8_MMA(1, 0, At, B0); PG8_MMA(1, 1, At, B1); PG8_BAR; PG8_SCHED;
        }
        if (wr == 0) PG8_BAR;
        E(acc, cur, wr, wc, fr, fq);
        if (!has_next) break;
        if (!Epi::CHAIN || cur.sub == 2) {
#pragma unroll
        for (int a = 0; a < 2; ++a)
#pragma unroll
            for (int b = 0; b < 2; ++b)
#pragma unroll
                for (int m = 0; m < 4; ++m)
#pragma unroll
                    for (int n = 0; n < 2; ++n) acc[a][b][m][n] = (f32x4){0.f, 0.f, 0.f, 0.f};
        }
        cur = nxt; cA = nA; cB = nB; ++ui;
        if (wr == 1) PG8_BAR;
    }
    PG8_WAIT_V(0);
    PG8_BAR;
#undef PG8_ABASE
#undef PG8_BBASE
#undef PG8_SA
#undef PG8_SB
#undef PG8_STAGE
#undef PG8_LDA
#undef PG8_LDB
#undef PG8_MMA
#undef PG8_WAIT_V
#undef PG8_WAIT_L
#undef PG8_BAR
#undef PG8_SCHED
}
}
using pg8::cvt_pk_bf16;

enum { EP_INPROJ = 0, EP_BF16, EP_MERGE0, EP_MERGE1, EP_MERGE2, EP_WOUT, EP_UP, EP_DOWN, EP_CHAIN, EP_DOWN_PART };
struct EpiArgs {
    bf16_t *QA, *KV, *QI, *UB, *QM, *G; float* KW32;
    bf16_t* O; int ldc; const float* cs;
    float* Y; const float* xp; const float* xs;
    bf16_t* HID;
    bf16_t* XG; float* SS; const float* gf;
};
__device__ __forceinline__ float sigmoidf_(float x) { return __builtin_amdgcn_rcpf(1.0f + __expf(-x)); }
__device__ __forceinline__ float bflo(unsigned u) { return __uint_as_float(u << 16); }
__device__ __forceinline__ float bfhi(unsigned u) { return __uint_as_float(u & 0xffff0000u); }

__device__ __forceinline__ void unpack8(const u32x4 q, float (&v)[8]);
template <int MODE> struct Epi {
    static constexpr bool CHAIN = (MODE == EP_CHAIN);
    EpiArgs p;
    __device__ __forceinline__ void operator()(f32x4 (&acc)[2][2][4][2], const pg8::Unit& u, int wr, int wc, int fr, int fq) const {
        const int row0 = u.pm * 256 + wr * 64 + fr, cw = wc * 32 + 8 * fq, pn = u.pn;
        if constexpr (MODE == EP_INPROJ) {
            if (pn == 4) {
                if (cw < 64) {
#pragma unroll
                    for (int ai = 0; ai < 2; ++ai)
#pragma unroll
                        for (int m = 0; m < 4; ++m) { float* d = p.KW32 + (size_t)(row0 + ai * 128 + m * 16) * 64 + cw;
                            *(f32x4*)d = acc[ai][0][m][0]; *(f32x4*)(d + 4) = acc[ai][0][m][1]; }
                }
                return;
            }
            bf16_t* base; int ld, co; bool sig = false;
            if (pn < 2) { base = p.QA; ld = 512; co = pn * 256; }
            else if (pn == 2) { base = p.KV; ld = 256; co = 0; }
            else if (pn == 3) { base = p.QI; ld = 256; co = 0; }
            else if (pn < 7) { base = p.UB; ld = 512; co = (pn - 5) * 256; }
            else if (pn < 9) { base = p.QM; ld = 512; co = (pn - 7) * 256; }
            else { base = p.G; ld = 3072; co = (pn - 9) * 256; sig = true; }
#pragma unroll
            for (int ai = 0; ai < 2; ++ai)
#pragma unroll
                for (int m = 0; m < 4; ++m) { bf16_t* rp = base + (size_t)(row0 + ai * 128 + m * 16) * ld + co + cw;
#pragma unroll
                    for (int bj = 0; bj < 2; ++bj) { f32x4 v0 = acc[ai][bj][m][0], v1 = acc[ai][bj][m][1];
                        if (sig) {
#pragma unroll
                            for (int e = 0; e < 4; ++e) { v0[e] = sigmoidf_(v0[e]); v1[e] = sigmoidf_(v1[e]); } }
                        u32x4 w; w.x = cvt_pk_bf16(v0[0], v0[1]); w.y = cvt_pk_bf16(v0[2], v0[3]); w.z = cvt_pk_bf16(v1[0], v1[1]); w.w = cvt_pk_bf16(v1[2], v1[3]);
                        *(u32x4*)(rp + bj * 128) = w; } }
        } else if constexpr (MODE == EP_BF16) {
#pragma unroll
            for (int ai = 0; ai < 2; ++ai)
#pragma unroll
                for (int m = 0; m < 4; ++m) { bf16_t* rp = p.O + (size_t)(row0 + ai * 128 + m * 16) * p.ldc + pn * 256 + cw;
#pragma unroll
                    for (int bj = 0; bj < 2; ++bj) { f32x4 v0 = acc[ai][bj][m][0], v1 = acc[ai][bj][m][1];
                        if (p.cs) { const float* c = p.cs + pn * 256 + bj * 128 + cw; v0 = v0 * *(const f32x4*)c; v1 = v1 * *(const f32x4*)(c + 4); }
                        u32x4 w; w.x = cvt_pk_bf16(v0[0], v0[1]); w.y = cvt_pk_bf16(v0[2], v0[3]); w.z = cvt_pk_bf16(v1[0], v1[1]); w.w = cvt_pk_bf16(v1[2], v1[3]);
                        *(u32x4*)(rp + bj * 128) = w; } }
        } else if constexpr (MODE == EP_MERGE0 || MODE == EP_MERGE1 || MODE == EP_MERGE2) {
            constexpr int kb = MODE - EP_MERGE0;
#pragma unroll
            for (int ai = 0; ai < 2; ++ai)
#pragma unroll
                for (int m = 0; m < 4; ++m) { const int row = row0 + ai * 128 + m * 16;
#pragma unroll
                    for (int bj = 0; bj < 2; ++bj) { const int col = pn * 256 + bj * 128 + cw;
                        const u32x4 gq = *(const u32x4*)(p.G + (size_t)row * 3072 + kb * 1024 + col);
                        f32x4 v0 = acc[ai][bj][m][0], v1 = acc[ai][bj][m][1];
                        v0[0] *= bflo(gq.x); v0[1] *= bfhi(gq.x); v0[2] *= bflo(gq.y); v0[3] *= bfhi(gq.y);
                        v1[0] *= bflo(gq.z); v1[1] *= bfhi(gq.z); v1[2] *= bflo(gq.w); v1[3] *= bfhi(gq.w);
                        float* y = p.Y + (size_t)row * 1024 + col;
                        if constexpr (kb == 0) { *(f32x4*)y = v0; *(f32x4*)(y + 4) = v1; }
                        else if constexpr (kb == 1) { *(f32x4*)y = *(const f32x4*)y + v0; *(f32x4*)(y + 4) = *(const f32x4*)(y + 4) + v1; }
                        else { v0 = v0 + *(const f32x4*)y; v1 = v1 + *(const f32x4*)(y + 4);
                            u32x4 w; w.x = cvt_pk_bf16(v0[0], v0[1]); w.y = cvt_pk_bf16(v0[2], v0[3]); w.z = cvt_pk_bf16(v1[0], v1[1]); w.w = cvt_pk_bf16(v1[2], v1[3]);
                            *(u32x4*)(p.G + (size_t)row * 3072 + col) = w; } } }
        } else if constexpr (MODE == EP_CHAIN) {
            const int sub = u.sub;
#pragma unroll
            for (int ai = 0; ai < 2; ++ai)
#pragma unroll
                for (int m = 0; m < 4; ++m) { const int row = row0 + ai * 128 + m * 16;
#pragma unroll
                    for (int bj = 0; bj < 2; ++bj) { const int col = pn * 256 + bj * 128 + cw;
                        bf16_t* gp = p.G + (size_t)row * 3072 + col;
                        float f[8];
                        if (sub == 2) { unpack8(*(const u32x4*)(gp + 2048), f); }
                        else { float nu[8], de[8]; unpack8(*(const u32x4*)(gp + sub * 1024), nu); unpack8(*(const u32x4*)(gp + (sub + 1) * 1024), de);
#pragma unroll
                            for (int e = 0; e < 8; ++e) f[e] = nu[e] * __builtin_amdgcn_rcpf(fmaxf(de[e], 1e-30f)); }
                        f32x4 v0 = acc[ai][bj][m][0], v1 = acc[ai][bj][m][1];
#pragma unroll
                        for (int e = 0; e < 4; ++e) { v0[e] *= f[e]; v1[e] *= f[4 + e]; }
                        acc[ai][bj][m][0] = v0; acc[ai][bj][m][1] = v1;
                        if (sub == 2) { u32x4 w; w.x = cvt_pk_bf16(v0[0], v0[1]); w.y = cvt_pk_bf16(v0[2], v0[3]); w.z = cvt_pk_bf16(v1[0], v1[1]); w.w = cvt_pk_bf16(v1[2], v1[3]);
                            *(u32x4*)gp = w; } } }
        } else if constexpr (MODE == EP_WOUT) {
#pragma unroll
            for (int ai = 0; ai < 2; ++ai)
#pragma unroll
                for (int m = 0; m < 4; ++m) { const int row = row0 + ai * 128 + m * 16;
                    const float* xr = row < MP ? p.xp + (size_t)row * 1024 : p.xs + (size_t)(row - MP) * 1024;
                    float ss = 0.f;
#pragma unroll
                    for (int bj = 0; bj < 2; ++bj) { const int col = pn * 256 + bj * 128 + cw;
                        const f32x4 a0 = *(const f32x4*)(xr + col) + acc[ai][bj][m][0], a1 = *(const f32x4*)(xr + col + 4) + acc[ai][bj][m][1];
                        ss += (a0[0] * a0[0] + a0[1] * a0[1]) + (a0[2] * a0[2] + a0[3] * a0[3]) + (a1[0] * a1[0] + a1[1] * a1[1]) + (a1[2] * a1[2] + a1[3] * a1[3]);
                        u32x4 w; w.x = cvt_pk_bf16(a0[0], a0[1]); w.y = cvt_pk_bf16(a0[2], a0[3]); w.z = cvt_pk_bf16(a1[0], a1[1]); w.w = cvt_pk_bf16(a1[2], a1[3]);
                        *(u32x4*)(p.XG + (size_t)row * 1024 + col) = w; }
                    ss += __shfl_xor(ss, 16); ss += __shfl_xor(ss, 32);
                    if (fq == 0) p.SS[(size_t)row * 16 + pn * 4 + wc] = ss; }
        } else if constexpr (MODE == EP_DOWN) {
#pragma unroll
            for (int ai = 0; ai < 2; ++ai)
#pragma unroll
                for (int m = 0; m < 4; ++m) { const int row = row0 + ai * 128 + m * 16;
#pragma unroll
                    for (int bj = 0; bj < 2; ++bj) { const int col = pn * 256 + bj * 128 + cw; float* y = p.Y + (size_t)row * 1024 + col;
                        float xv[8]; unpack8(*(const u32x4*)(p.XG + (size_t)row * 1024 + col), xv);
                        *(f32x4*)y = (f32x4){xv[0], xv[1], xv[2], xv[3]} + acc[ai][bj][m][0]; *(f32x4*)(y + 4) = (f32x4){xv[4], xv[5], xv[6], xv[7]} + acc[ai][bj][m][1]; } }
        } else if constexpr (MODE == EP_DOWN_PART) {
#pragma unroll
            for (int ai = 0; ai < 2; ++ai)
#pragma unroll
                for (int m = 0; m < 4; ++m) { const int rl = row0 + ai * 128 + m * 16;
#pragma unroll
                    for (int bj = 0; bj < 2; ++bj) { float* y = p.Y + ((size_t)(pn >> 2) * 1024 + rl) * 1024 + (pn & 3) * 256 + bj * 128 + cw;
                        *(f32x4*)y = acc[ai][bj][m][0]; *(f32x4*)(y + 4) = acc[ai][bj][m][1]; } }
        } else if constexpr (MODE == EP_UP) {
#pragma unroll
            for (int ai = 0; ai < 2; ++ai)
#pragma unroll
                for (int m = 0; m < 4; ++m) { const int row = row0 + ai * 128 + m * 16;
                    const f32x4* sp = (const f32x4*)(p.SS + (size_t)row * 16); const f32x4 q0 = sp[0], q1 = sp[1], q2 = sp[2], q3 = sp[3];
                    const float tot = ((q0[0] + q0[1]) + (q0[2] + q0[3])) + ((q1[0] + q1[1]) + (q1[2] + q1[3])) + ((q2[0] + q2[1]) + (q2[2] + q2[3])) + ((q3[0] + q3[1]) + (q3[2] + q3[3]));
                    const float rstd = rsqrtf(tot * (1.f / 1024.f) + EPS);
                    f32x4 v0, v1;
#pragma unroll
                    for (int e = 0; e < 4; ++e) { const float g0 = acc[ai][0][m][0][e] * rstd, g1 = acc[ai][0][m][1][e] * rstd;
                        v0[e] = g0 * sigmoidf_(g0) * (acc[ai][1][m][0][e] * rstd); v1[e] = g1 * sigmoidf_(g1) * (acc[ai][1][m][1][e] * rstd); }
                    u32x4 w; w.x = cvt_pk_bf16(v0[0], v0[1]); w.y = cvt_pk_bf16(v0[2], v0[3]); w.z = cvt_pk_bf16(v1[0], v1[1]); w.w = cvt_pk_bf16(v1[2], v1[3]);
                    *(u32x4*)(p.HID + (size_t)row * DFF + pn * 128 + cw) = w; }
        }
    }
};

__device__ __forceinline__ float wave_sum(float v) {
#pragma unroll
    for (int o = 1; o < 64; o <<= 1) v += __shfl_xor(v, o);
    return v;
}
__device__ __forceinline__ void sincos_red(float a, float& s, float& c) {
    const float k = rintf(a * 0.15915494309189535f);
    float r = fmaf(-k, 6.28125f, a);
    r = fmaf(-k, 1.9353071795864769e-3f, r);
    s = __sinf(r); c = __cosf(r);
}
__device__ __forceinline__ void unpack8(const u32x4 q, float (&v)[8]) {
    v[0] = bflo(q.x); v[1] = bfhi(q.x); v[2] = bflo(q.y); v[3] = bfhi(q.y); v[4] = bflo(q.z); v[5] = bfhi(q.z); v[6] = bflo(q.w); v[7] = bfhi(q.w);
}
__device__ __forceinline__ u32x4 pack8(const float (&v)[8]) {
    u32x4 w; w.x = cvt_pk_bf16(v[0], v[1]); w.y = cvt_pk_bf16(v[2], v[3]); w.z = cvt_pk_bf16(v[4], v[5]); w.w = cvt_pk_bf16(v[6], v[7]); return w;
}
__device__ __forceinline__ void rms_row_1024(const float* xr, const float* g, bf16_t* o, int lane) {
    const f32x4* x4 = (const f32x4*)xr + lane; f32x4 v[4]; float s = 0.f;
#pragma unroll
    for (int j = 0; j < 4; ++j) { v[j] = x4[64 * j]; s += (v[j].x * v[j].x + v[j].y * v[j].y) + (v[j].z * v[j].z + v[j].w * v[j].w); }
    const float rstd = rsqrtf(wave_sum(s) * (1.f / 1024.f) + EPS);
#pragma unroll
    for (int j = 0; j < 4; ++j) { const f32x4 gg = ((const f32x4*)g)[lane + 64 * j];
        u32x2 w; w.x = cvt_pk_bf16(v[j].x * rstd * gg.x, v[j].y * rstd * gg.y); w.y = cvt_pk_bf16(v[j].z * rstd * gg.z, v[j].w * rstd * gg.w);
        *(u32x2*)(o + 4 * lane + 256 * j) = w; }
}
__device__ __forceinline__ void transpose_item(const float* W, int N, int K, bf16_t* WT, int k0, int n0, int col, LAS float* scr, int lane, const float* kscale = nullptr) {
    float tv[32];
#pragma unroll
    for (int i = 0; i < 32; ++i) { const int kk = 2 * i + (lane >> 5); tv[i] = (col >= 0) ? W[(size_t)(k0 + kk) * N + col] : 0.f; }
#pragma unroll
    for (int i = 0; i < 32; ++i) { const int kk = 2 * i + (lane >> 5); scr[kk * 33 + (lane & 31)] = kscale ? tv[i] * kscale[k0 + kk] : tv[i]; }
    asm volatile("s_waitcnt lgkmcnt(0)" ::: "memory");
    const int c = lane & 7;
#pragma unroll
    for (int j = 0; j < 4; ++j) { const int n = (lane >> 3) + 8 * j; const LAS float* s = scr + (8 * c) * 33 + n;
        u32x4 o; o.x = cvt_pk_bf16(s[0 * 33], s[1 * 33]); o.y = cvt_pk_bf16(s[2 * 33], s[3 * 33]); o.z = cvt_pk_bf16(s[4 * 33], s[5 * 33]); o.w = cvt_pk_bf16(s[6 * 33], s[7 * 33]);
        *(u32x4*)(WT + (size_t)(n0 + n) * K + k0 + 8 * c) = o; }
    asm volatile("s_waitcnt lgkmcnt(0)" ::: "memory");
}
__device__ __forceinline__ int map_in(int n) {
    if (n < 1024) return n;
    if (n < 1280) return (n - 1024 < 40) ? n : -1;
    if (n < 1792) return 1064 + (n - 1280);
    if (n < 2304) return 1576 + (n - 1792);
    return 2088 + (n - 2304);
}

struct Args { const float* in[28]; float* out; unsigned char* ws; };

#define MFMA16(a, b, c) __builtin_amdgcn_mfma_f32_16x16x32_bf16((a), (b), (c), 0, 0, 0)
#define MFMA32(a, b, c) __builtin_amdgcn_mfma_f32_32x32x16_bf16((a), (b), (c), 0, 0, 0)
__device__ __forceinline__ bf16x8 pack_p(const f32x4 a, const f32x4 b) {
    u32x4 w; w.x = cvt_pk_bf16(a[0], a[1]); w.y = cvt_pk_bf16(a[2], a[3]); w.z = cvt_pk_bf16(b[0], b[1]); w.w = cvt_pk_bf16(b[2], b[3]);
    return __builtin_bit_cast(bf16x8, w);
}

__device__ __forceinline__ void mem_attn_item(const bf16_t* QM, const bf16_t* Kb  , const bf16_t* VTb  , bf16_t* Mo, int r0, int h, int lane) {
    const int c = lane & 15, q = lane >> 4;
    bf16x8 Bq[4];
#pragma unroll
    for (int ks = 0; ks < 4; ++ks) Bq[ks] = *(const bf16x8*)(QM + (size_t)(r0 + c) * 512 + h * 128 + 32 * ks + 8 * q);
    f32x4 S[16];
#pragma unroll
    for (int kt = 0; kt < 16; ++kt) {
        const bf16_t* kp = Kb + (size_t)(16 * kt + c) * 512 + h * 128 + 8 * q;
        f32x4 s = (f32x4){0.f, 0.f, 0.f, 0.f};
#pragma unroll
        for (int ks = 0; ks < 4; ++ks) s = MFMA16(*(const bf16x8*)(kp + 32 * ks), Bq[ks], s);
        S[kt] = s;
    }
    const float sc = 0.08838834764831845f * 1.4426950408889634f;
    float mx = -3.0e38f;
#pragma unroll
    for (int kt = 0; kt < 16; ++kt)
#pragma unroll
        for (int e = 0; e < 4; ++e) mx = fmaxf(mx, S[kt][e]);
    mx = fmaxf(mx, __shfl_xor(mx, 16)); mx = fmaxf(mx, __shfl_xor(mx, 32));
    float sum = 0.f;
#pragma unroll
    for (int kt = 0; kt < 16; ++kt)
#pragma unroll
        for (int e = 0; e < 4; ++e) { const float pe = __builtin_amdgcn_exp2f((S[kt][e] - mx) * sc); S[kt][e] = pe; sum += pe; }
    sum += __shfl_xor(sum, 16); sum += __shfl_xor(sum, 32);
    const float inv = 1.0f / sum;
    f32x4 O[8];
#pragma unroll
    for (int dt = 0; dt < 8; ++dt) O[dt] = (f32x4){0.f, 0.f, 0.f, 0.f};
#pragma unroll
    for (int u = 0; u < 8; ++u) {
        const bf16x8 Bp = pack_p(S[2 * u] * inv, S[2 * u + 1] * inv);
#pragma unroll
        for (int dt = 0; dt < 8; ++dt) {
            const bf16_t* vp = VTb + (size_t)(16 * dt + c) * 256 + 32 * u + 4 * q;
            const u32x2 lo = *(const u32x2*)vp, hi = *(const u32x2*)(vp + 16);
            u32x4 w; w.x = lo.x; w.y = lo.y; w.z = hi.x; w.w = hi.y;
            O[dt] = MFMA16(__builtin_bit_cast(bf16x8, w), Bp, O[dt]);
        }
    }
#pragma unroll
    for (int dt = 0; dt < 8; ++dt) { u32x2 w; w.x = cvt_pk_bf16(O[dt][0], O[dt][1]); w.y = cvt_pk_bf16(O[dt][2], O[dt][3]);
        *(u32x2*)(Mo + (size_t)(r0 + c) * 512 + h * 128 + 16 * dt + 4 * q) = w; }
}

__device__ __forceinline__ void sparse_attn_query(const bf16_t* QA, const bf16_t* kvb, bf16_t* Ao, int row, const LAS unsigned short* sel, int ntile, int lane) {
    const int c = lane & 15, q = lane >> 4;
#pragma unroll 1
    for (int g = 0; g < 2; ++g) {
        bf16x8 Bq[2];
#pragma unroll
        for (int ks = 0; ks < 2; ++ks) { u32x4 z = (u32x4){0u, 0u, 0u, 0u};
            if (c < 4) z = *(const u32x4*)(QA + (size_t)row * 512 + (4 * g + c) * 64 + 32 * ks + 8 * q);
            Bq[ks] = __builtin_bit_cast(bf16x8, z); }
        const unsigned kofs = (unsigned)(g * 64 + 8 * q) * 2u;
        bf16x8 KA[16][2];
#pragma unroll
        for (int kt = 0; kt < 16; ++kt) { const unsigned ko = (unsigned)sel[16 * kt + c] * 512u + kofs;
            KA[kt][0] = *(const bf16x8*)((const char*)kvb + ko); KA[kt][1] = *(const bf16x8*)((const char*)kvb + ko + 64u); }
        f32x4 S[16];
#pragma unroll
        for (int kt = 0; kt < 16; ++kt) {
            f32x4 s = MFMA16(KA[kt][0], Bq[0], ((f32x4){0.f, 0.f, 0.f, 0.f}));
            s = MFMA16(KA[kt][1], Bq[1], s);
            const bool ok = kt < ntile;
#pragma unroll
            for (int e = 0; e < 4; ++e) s[e] = ok ? s[e] : -__builtin_inff();
            S[kt] = s;
        }
#define VLOAD(XX, u0, nu) do { _Pragma("unroll") for (int u_ = 0; u_ < nu; ++u_) { \
            const u32x2 s0_ = *(const LAS u32x2*)(sel + 32 * (u0 + u_) + 4 * q), s1_ = *(const LAS u32x2*)(sel + 32 * (u0 + u_) + 16 + 4 * q); \
            int sid_[8]; sid_[0] = s0_.x & 0xffff; sid_[1] = s0_.x >> 16; sid_[2] = s0_.y & 0xffff; sid_[3] = s0_.y >> 16; sid_[4] = s1_.x & 0xffff; sid_[5] = s1_.x >> 16; sid_[6] = s1_.y & 0xffff; sid_[7] = s1_.y >> 16; \
            _Pragma("unroll") for (int e_ = 0; e_ < 8; ++e_) XX[u_][e_] = *(const u32x2*)((const char*)kvb + ((unsigned)sid_[e_] * 512u + vofs)); } } while (0)
#define PVSTEP(XX, u0, nu) do { _Pragma("unroll") for (int u_ = 0; u_ < nu; ++u_) { u32x4 w0, w1, w2, w3; \
            w0.x = __builtin_amdgcn_perm(XX[u_][1].x, XX[u_][0].x, 0x05040100u); w0.y = __builtin_amdgcn_perm(XX[u_][3].x, XX[u_][2].x, 0x05040100u); w0.z = __builtin_amdgcn_perm(XX[u_][5].x, XX[u_][4].x, 0x05040100u); w0.w = __builtin_amdgcn_perm(XX[u_][7].x, XX[u_][6].x, 0x05040100u); \
            w1.x = __builtin_amdgcn_perm(XX[u_][1].x, XX[u_][0].x, 0x07060302u); w1.y = __builtin_amdgcn_perm(XX[u_][3].x, XX[u_][2].x, 0x07060302u); w1.z = __builtin_amdgcn_perm(XX[u_][5].x, XX[u_][4].x, 0x07060302u); w1.w = __builtin_amdgcn_perm(XX[u_][7].x, XX[u_][6].x, 0x07060302u); \
            w2.x = __builtin_amdgcn_perm(XX[u_][1].y, XX[u_][0].y, 0x05040100u); w2.y = __builtin_amdgcn_perm(XX[u_][3].y, XX[u_][2].y, 0x05040100u); w2.z = __builtin_amdgcn_perm(XX[u_][5].y, XX[u_][4].y, 0x05040100u); w2.w = __builtin_amdgcn_perm(XX[u_][7].y, XX[u_][6].y, 0x05040100u); \
            w3.x = __builtin_amdgcn_perm(XX[u_][1].y, XX[u_][0].y, 0x07060302u); w3.y = __builtin_amdgcn_perm(XX[u_][3].y, XX[u_][2].y, 0x07060302u); w3.z = __builtin_amdgcn_perm(XX[u_][5].y, XX[u_][4].y, 0x07060302u); w3.w = __builtin_amdgcn_perm(XX[u_][7].y, XX[u_][6].y, 0x07060302u); \
            O[0] = MFMA16(Pk[u0 + u_], __builtin_bit_cast(bf16x8, w0), O[0]); O[1] = MFMA16(Pk[u0 + u_], __builtin_bit_cast(bf16x8, w1), O[1]); \
            O[2] = MFMA16(Pk[u0 + u_], __builtin_bit_cast(bf16x8, w2), O[2]); O[3] = MFMA16(Pk[u0 + u_], __builtin_bit_cast(bf16x8, w3), O[3]); } } while (0)
        const unsigned vofs = (unsigned)(128 + g * 64 + 4 * c) * 2u;
        __builtin_amdgcn_sched_barrier(0);
        u32x2 X0[4][8]; VLOAD(X0, 0, 4);
        __builtin_amdgcn_sched_barrier(0);
        const float sc = 0.125f * 1.4426950408889634f;
        float mx = -3.0e38f;
#pragma unroll
        for (int kt = 0; kt < 16; ++kt)
#pragma unroll
            for (int e = 0; e < 4; ++e) mx = fmaxf(mx, S[kt][e]);
        mx = fmaxf(mx, __shfl_xor(mx, 16)); mx = fmaxf(mx, __shfl_xor(mx, 32));
        float sum = 0.f;
#pragma unroll
        for (int kt = 0; kt < 16; ++kt)
#pragma unroll
            for (int e = 0; e < 4; ++e) { const float pe = __builtin_amdgcn_exp2f((S[kt][e] - mx) * sc); S[kt][e] = pe; sum += pe; }
        sum += __shfl_xor(sum, 16); sum += __shfl_xor(sum, 32);
        const float inv = 1.0f / sum;
        bf16x8 Pk[8];
#pragma unroll
        for (int u = 0; u < 8; ++u) Pk[u] = pack_p(S[2 * u] * inv, S[2 * u + 1] * inv);
        __builtin_amdgcn_sched_barrier(0);
        u32x2 X1[2][8]; VLOAD(X1, 4, 2);
        __builtin_amdgcn_sched_barrier(0);
        f32x4 O[4];
#pragma unroll
        for (int dt = 0; dt < 4; ++dt) O[dt] = (f32x4){0.f, 0.f, 0.f, 0.f};
        PVSTEP(X0, 0, 4);
        __builtin_amdgcn_sched_barrier(0);
        u32x2 X2[2][8]; VLOAD(X2, 6, 2);
        __builtin_amdgcn_sched_barrier(0);
        PVSTEP(X1, 4, 2);
        PVSTEP(X2, 6, 2);
#undef VLOAD
#undef PVSTEP
        if (q == 0) {
#pragma unroll
            for (int hh = 0; hh < 4; ++hh) { u32x2 w; w.x = cvt_pk_bf16(O[0][hh], O[1][hh]); w.y = cvt_pk_bf16(O[2][hh], O[3][hh]);
                *(u32x2*)(Ao + (size_t)row * 512 + (4 * g + hh) * 64 + 4 * c) = w; }
        }
    }
}

__device__ __forceinline__ u32x2 pack8_fp8(const float (&v)[8]) {
    int a = __builtin_amdgcn_cvt_pk_fp8_f32(v[0], v[1], 0, false); a = __builtin_amdgcn_cvt_pk_fp8_f32(v[2], v[3], a, true);
    int b = __builtin_amdgcn_cvt_pk_fp8_f32(v[4], v[5], 0, false); b = __builtin_amdgcn_cvt_pk_fp8_f32(v[6], v[7], b, true);
    u32x2 r; r.x = (unsigned)a; r.y = (unsigned)b; return r;
}
__device__ __forceinline__ long mk64(unsigned lo, unsigned hi) { return (long)(((unsigned long long)hi << 32) | (unsigned long long)lo); }
__device__ __forceinline__ void sparse_attn_query8(const unsigned char* QA8, const unsigned char* kv8, bf16_t* Ao, int row, const LAS unsigned short* sel, int ntile, int lane) {
    const int c = lane & 15, q = lane >> 4;
#pragma unroll 1
    for (int g = 0; g < 2; ++g) {
        long Bq[2];
#pragma unroll
        for (int ks = 0; ks < 2; ++ks) { u32x2 z = (u32x2){0u, 0u};
            if (c < 4) z = *(const u32x2*)(QA8 + (size_t)row * 512 + (4 * g + c) * 64 + 16 * q + 8 * ks);
            Bq[ks] = mk64(z.x, z.y); }
        const unsigned kofs = (unsigned)(g * 64 + 16 * q), vofs = (unsigned)(128 + g * 64 + 4 * c);
        u32x4 KA[16];
#pragma unroll
        for (int kt = 0; kt < 16; ++kt) { const unsigned ko = (unsigned)sel[16 * kt + c] * 256u + kofs;
            KA[kt] = *(const u32x4*)(kv8 + ko); }
        unsigned XV[8][8];
#pragma unroll
        for (int u = 0; u < 8; ++u) {
            const u32x2 s0 = *(const LAS u32x2*)(sel + 32 * u + 4 * q), s1 = *(const LAS u32x2*)(sel + 32 * u + 16 + 4 * q);
            unsigned sid[8]; sid[0] = s0.x & 0xffffu; sid[1] = s0.x >> 16; sid[2] = s0.y & 0xffffu; sid[3] = s0.y >> 16; sid[4] = s1.x & 0xffffu; sid[5] = s1.x >> 16; sid[6] = s1.y & 0xffffu; sid[7] = s1.y >> 16;
#pragma unroll
            for (int e = 0; e < 8; ++e) XV[u][e] = *(const unsigned*)(kv8 + (sid[e] * 256u + vofs));
        }
        f32x4 S[16];
#pragma unroll
        for (int kt = 0; kt < 16; ++kt) {
            f32x4 s = __builtin_amdgcn_mfma_f32_16x16x32_fp8_fp8(mk64(KA[kt].x, KA[kt].y), Bq[0], ((f32x4){0.f, 0.f, 0.f, 0.f}), 0, 0, 0);
            s = __builtin_amdgcn_mfma_f32_16x16x32_fp8_fp8(mk64(KA[kt].z, KA[kt].w), Bq[1], s, 0, 0, 0);
            const bool ok = kt < ntile;
#pragma unroll
            for (int e = 0; e < 4; ++e) s[e] = ok ? s[e] : -__builtin_inff();
            S[kt] = s;
        }
        const float sc = 0.125f * 1.4426950408889634f;
        float mx = -3.0e38f;
#pragma unroll
        for (int kt = 0; kt < 16; ++kt)
#pragma unroll
            for (int e = 0; e < 4; ++e) mx = fmaxf(mx, S[kt][e]);
        mx = fmaxf(mx, __shfl_xor(mx, 16)); mx = fmaxf(mx, __shfl_xor(mx, 32));
        float sum = 0.f;
#pragma unroll
        for (int kt = 0; kt < 16; ++kt)
#pragma unroll
            for (int e = 0; e < 4; ++e) { const float pe = __builtin_amdgcn_exp2f((S[kt][e] - mx) * sc); S[kt][e] = pe; sum += pe; }
        sum += __shfl_xor(sum, 16); sum += __shfl_xor(sum, 32);
        const float inv = 1.0f / sum;
        f32x4 O[4];
#pragma unroll
        for (int dt = 0; dt < 4; ++dt) O[dt] = (f32x4){0.f, 0.f, 0.f, 0.f};
#pragma unroll
        for (int u = 0; u < 8; ++u) {
            int p0 = __builtin_amdgcn_cvt_pk_bf8_f32(S[2 * u][0], S[2 * u][1], 0, false); p0 = __builtin_amdgcn_cvt_pk_bf8_f32(S[2 * u][2], S[2 * u][3], p0, true);
            int p1 = __builtin_amdgcn_cvt_pk_bf8_f32(S[2 * u + 1][0], S[2 * u + 1][1], 0, false); p1 = __builtin_amdgcn_cvt_pk_bf8_f32(S[2 * u + 1][2], S[2 * u + 1][3], p1, true);
            const long Pk = mk64((unsigned)p0, (unsigned)p1);
            const unsigned a0 = __builtin_amdgcn_perm(XV[u][1], XV[u][0], 0x05010400u), b0 = __builtin_amdgcn_perm(XV[u][1], XV[u][0], 0x07030602u);
            const unsigned c0 = __builtin_amdgcn_perm(XV[u][3], XV[u][2], 0x05010400u), d0 = __builtin_amdgcn_perm(XV[u][3], XV[u][2], 0x07030602u);
            const unsigned a1 = __builtin_amdgcn_perm(XV[u][5], XV[u][4], 0x05010400u), b1 = __builtin_amdgcn_perm(XV[u][5], XV[u][4], 0x07030602u);
            const unsigned c1 = __builtin_amdgcn_perm(XV[u][7], XV[u][6], 0x05010400u), d1 = __builtin_amdgcn_perm(XV[u][7], XV[u][6], 0x07030602u);
            const long V0 = mk64(__builtin_amdgcn_perm(c0, a0, 0x05040100u), __builtin_amdgcn_perm(c1, a1, 0x05040100u));
            const long V1 = mk64(__builtin_amdgcn_perm(c0, a0, 0x07060302u), __builtin_amdgcn_perm(c1, a1, 0x07060302u));
            const long V2 = mk64(__builtin_amdgcn_perm(d0, b0, 0x05040100u), __builtin_amdgcn_perm(d1, b1, 0x05040100u));
            const long V3 = mk64(__builtin_amdgcn_perm(d0, b0, 0x07060302u), __builtin_amdgcn_perm(d1, b1, 0x07060302u));
            O[0] = __builtin_amdgcn_mfma_f32_16x16x32_bf8_fp8(Pk, V0, O[0], 0, 0, 0);
            O[1] = __builtin_amdgcn_mfma_f32_16x16x32_bf8_fp8(Pk, V1, O[1], 0, 0, 0);
            O[2] = __builtin_amdgcn_mfma_f32_16x16x32_bf8_fp8(Pk, V2, O[2], 0, 0, 0);
            O[3] = __builtin_amdgcn_mfma_f32_16x16x32_bf8_fp8(Pk, V3, O[3], 0, 0, 0);
        }
        float invh[4];
#pragma unroll
        for (int hh = 0; hh < 4; ++hh) invh[hh] = __shfl(inv, hh);
        if (q == 0) {
#pragma unroll
            for (int hh = 0; hh < 4; ++hh) { u32x2 w; w.x = cvt_pk_bf16(O[0][hh] * invh[hh], O[1][hh] * invh[hh]); w.y = cvt_pk_bf16(O[2][hh] * invh[hh], O[3][hh] * invh[hh]);
                *(u32x2*)(Ao + (size_t)row * 512 + (4 * g + hh) * 64 + 4 * c) = w; }
        }
    }
}

template <int NQ>
__device__ __forceinline__ void sparse_attn_lds(const unsigned char* QA8, const unsigned char* kv8, bf16_t* Ao, int qrow0, const LAS unsigned short* selb, LAS unsigned char* buf, int nch, int lane) {
    const int c = lane & 15, q = lane >> 4;
    long Bq[NQ][2][2];
#pragma unroll
    for (int qq = 0; qq < NQ; ++qq)
#pragma unroll
        for (int g = 0; g < 2; ++g)
#pragma unroll
            for (int ks = 0; ks < 2; ++ks) { u32x2 z = (u32x2){0u, 0u};
                if (c < 4) z = *(const u32x2*)(QA8 + (size_t)(qrow0 + qq) * 512 + (4 * g + c) * 64 + 16 * q + 8 * ks);
                Bq[qq][g][ks] = mk64(z.x, z.y); }
    const int nsteps = NQ * nch;
    asm volatile("s_waitcnt lgkmcnt(0)" ::: "memory");
#define DMA_CHUNK(qq_, u_) do { const LAS unsigned short* sp_ = selb + (qq_) * 256 + (u_) * 32; LAS unsigned char* db_ = buf + ((u_) & 1) * 8192; \
        _Pragma("unroll") for (int p = 0; p < 8; ++p) { const int r_ = 4 * p + q; const unsigned src_ = (unsigned)sp_[r_] * 256u + 16u * (unsigned)(c ^ (r_ & 15)); \
            __builtin_amdgcn_global_load_lds((const unsigned*)(kv8 + src_), (LAS unsigned*)(db_ + p * 1024), 16, 0, 0); } } while (0)
    DMA_CHUNK(0, 0);
    DMA_CHUNK(0, 1);
    const float sc = 0.125f * 1.4426950408889634f;
    int sidx = 0;
#pragma unroll
    for (int qq = 0; qq < NQ; ++qq) {
        float m0 = -3.0e38f, m1 = -3.0e38f, l0 = 0.f, l1 = 0.f;
        f32x4 O[2][4];
#pragma unroll
        for (int g = 0; g < 2; ++g)
#pragma unroll
            for (int dt = 0; dt < 4; ++dt) O[g][dt] = (f32x4){0.f, 0.f, 0.f, 0.f};
#pragma unroll 1
        for (int u = 0; u < nch; ++u, ++sidx) {
            if (sidx + 1 < nsteps) asm volatile("s_waitcnt vmcnt(8)" ::: "memory"); else asm volatile("s_waitcnt vmcnt(0)" ::: "memory");
            const LAS unsigned char* b_ = buf + (u & 1) * 8192;
#pragma unroll
            for (int g = 0; g < 2; ++g) {
                const unsigned kslot = (unsigned)(((4 * g + q) ^ c) * 16);
                const u32x4 ka0 = *(const LAS u32x4*)(b_ + c * 256 + kslot), ka1 = *(const LAS u32x4*)(b_ + (16 + c) * 256 + kslot);
                f32x4 s0 = __builtin_amdgcn_mfma_f32_16x16x32_fp8_fp8(mk64(ka0.x, ka0.y), Bq[qq][g][0], ((f32x4){0.f, 0.f, 0.f, 0.f}), 0, 0, 0);
                s0 = __builtin_amdgcn_mfma_f32_16x16x32_fp8_fp8(mk64(ka0.z, ka0.w), Bq[qq][g][1], s0, 0, 0, 0);
                f32x4 s1 = __builtin_amdgcn_mfma_f32_16x16x32_fp8_fp8(mk64(ka1.x, ka1.y), Bq[qq][g][0], ((f32x4){0.f, 0.f, 0.f, 0.f}), 0, 0, 0);
                s1 = __builtin_amdgcn_mfma_f32_16x16x32_fp8_fp8(mk64(ka1.z, ka1.w), Bq[qq][g][1], s1, 0, 0, 0);
                float cm = fmaxf(fmaxf(fmaxf(s0[0], s0[1]), fmaxf(s0[2], s0[3])), fmaxf(fmaxf(s1[0], s1[1]), fmaxf(s1[2], s1[3])));
                cm = fmaxf(cm, __shfl_xor(cm, 16)); cm = fmaxf(cm, __shfl_xor(cm, 32));
                const float mo = g ? m1 : m0, mn = fmaxf(mo, cm);
                const float al = __builtin_amdgcn_exp2f((mo - mn) * sc);
                float ls = 0.f;
#pragma unroll
                for (int e = 0; e < 4; ++e) { s0[e] = __builtin_amdgcn_exp2f((s0[e] - mn) * sc); s1[e] = __builtin_amdgcn_exp2f((s1[e] - mn) * sc); ls += s0[e] + s1[e]; }
                if (g) { m1 = mn; l1 = l1 * al + ls; } else { m0 = mn; l0 = l0 * al + ls; }
                float ah[4];
#pragma unroll
                for (int h = 0; h < 4; ++h) ah[h] = __int_as_float(__builtin_amdgcn_readlane(__float_as_int(al), h));
#pragma unroll
                for (int dt = 0; dt < 4; ++dt)
#pragma unroll
                    for (int h = 0; h < 4; ++h) O[g][dt][h] *= ah[h];
                int p0 = __builtin_amdgcn_cvt_pk_bf8_f32(s0[0], s0[1], 0, false); p0 = __builtin_amdgcn_cvt_pk_bf8_f32(s0[2], s0[3], p0, true);
                int p1 = __builtin_amdgcn_cvt_pk_bf8_f32(s1[0], s1[1], 0, false); p1 = __builtin_amdgcn_cvt_pk_bf8_f32(s1[2], s1[3], p1, true);
                const long Pk = mk64((unsigned)p0, (unsigned)p1);
                unsigned xv[8];
#pragma unroll
                for (int e = 0; e < 8; ++e) { const int r_ = (e < 4) ? 4 * q + e : 16 + 4 * q + (e - 4);
                    xv[e] = *(const LAS unsigned*)(b_ + r_ * 256 + 16 * ((8 + 4 * g + (c >> 2)) ^ (r_ & 15)) + 4 * (c & 3)); }
                const unsigned a0 = __builtin_amdgcn_perm(xv[1], xv[0], 0x05010400u), b0 = __builtin_amdgcn_perm(xv[1], xv[0], 0x07030602u);
                const unsigned c0 = __builtin_amdgcn_perm(xv[3], xv[2], 0x05010400u), d0 = __builtin_amdgcn_perm(xv[3], xv[2], 0x07030602u);
                const unsigned a1 = __builtin_amdgcn_perm(xv[5], xv[4], 0x05010400u), b1 = __builtin_amdgcn_perm(xv[5], xv[4], 0x07030602u);
                const unsigned c1 = __builtin_amdgcn_perm(xv[7], xv[6], 0x05010400u), d1 = __builtin_amdgcn_perm(xv[7], xv[6], 0x07030602u);
                O[g][0] = __builtin_amdgcn_mfma_f32_16x16x32_bf8_fp8(Pk, mk64(__builtin_amdgcn_perm(c0, a0, 0x05040100u), __builtin_amdgcn_perm(c1, a1, 0x05040100u)), O[g][0], 0, 0, 0);
                O[g][1] = __builtin_amdgcn_mfma_f32_16x16x32_bf8_fp8(Pk, mk64(__builtin_amdgcn_perm(c0, a0, 0x07060302u), __builtin_amdgcn_perm(c1, a1, 0x07060302u)), O[g][1], 0, 0, 0);
                O[g][2] = __builtin_amdgcn_mfma_f32_16x16x32_bf8_fp8(Pk, mk64(__builtin_amdgcn_perm(d0, b0, 0x05040100u), __builtin_amdgcn_perm(d1, b1, 0x05040100u)), O[g][2], 0, 0, 0);
                O[g][3] = __builtin_amdgcn_mfma_f32_16x16x32_bf8_fp8(Pk, mk64(__builtin_amdgcn_perm(d0, b0, 0x07060302u), __builtin_amdgcn_perm(d1, b1, 0x07060302u)), O[g][3], 0, 0, 0);
            }
            if (u == nch - 1) {
#pragma unroll
                for (int g = 0; g < 2; ++g) {
                    float lt = g ? l1 : l0; lt += __shfl_xor(lt, 16); lt += __shfl_xor(lt, 32);
                    const float inv = 1.0f / lt;
                    float ih[4];
#pragma unroll
                    for (int h = 0; h < 4; ++h) ih[h] = __int_as_float(__builtin_amdgcn_readlane(__float_as_int(inv), h));
                    if (q == 0) {
#pragma unroll
                        for (int h = 0; h < 4; ++h) { u32x2 w; w.x = cvt_pk_bf16(O[g][0][h] * ih[h], O[g][1][h] * ih[h]); w.y = cvt_pk_bf16(O[g][2][h] * ih[h], O[g][3][h] * ih[h]);
                            *(u32x2*)(Ao + (size_t)(qrow0 + qq) * 512 + (4 * g + h) * 64 + 4 * c) = w; }
                    }
                }
            }
            asm volatile("s_waitcnt lgkmcnt(0)" ::: "memory");
            if (sidx + 2 < nsteps) { int nq_ = qq, nu_ = u + 2; if (nu_ >= nch) { nu_ -= nch; nq_ += 1; } DMA_CHUNK(nq_, nu_); }
        }
    }
#undef DMA_CHUNK
}

__device__ __forceinline__ void scan_hist(const LAS unsigned* hq, int need, int lane, int& bin, int& above) {
    int sum = 0;
#pragma unroll
    for (int w = 0; w < 16; ++w) { const unsigned x = hq[16 * lane + w]; sum += (int)(x & 0xffffu) + (int)(x >> 16); }
    int suf = sum;
#pragma unroll
    for (int off = 1; off < 64; off <<= 1) { const int v = __shfl_down(suf, off); if (lane + off < 64) suf += v; }
    int nx = __shfl_down(suf, 1); if (lane == 63) nx = 0;
    const bool hit = (suf >= need) && (nx < need);
    const unsigned long long mk = __ballot(hit);
    const int L = mk ? (int)__builtin_ctzll(mk) : 0;
    const int aboveL = __shfl(nx, L);
    const unsigned xw = hq[16 * L + ((lane & 31) >> 1)];
    int cj = (lane & 1) ? (int)(xw >> 16) : (int)(xw & 0xffffu); if (lane >= 32) cj = 0;
    int suf2 = cj;
#pragma unroll
    for (int off = 1; off < 32; off <<= 1) { const int v = __shfl_down(suf2, off); if (lane + off < 64) suf2 += v; }
    int nx2 = __shfl_down(suf2, 1); if (lane == 63) nx2 = 0;
    const int need2 = need - aboveL;
    const bool hit2 = (lane < 32) && (suf2 >= need2) && (nx2 < need2);
    const unsigned long long mk2 = __ballot(hit2);
    const int J = mk2 ? (int)__builtin_ctzll(mk2) : 0;
    bin = 32 * L + J; above = aboveL + __shfl(nx2, J);
}

__device__ __forceinline__ void scan_hist1024(const LAS unsigned* hq, int need, int lane, int& bin, int& above, int& inbin) {
    int sum = 0;
#pragma unroll
    for (int w = 0; w < 8; ++w) { const unsigned x = hq[8 * lane + w]; sum += (int)(x & 0xffffu) + (int)(x >> 16); }
    int suf = sum;
#pragma unroll
    for (int off = 1; off < 64; off <<= 1) { const int v = __shfl_down(suf, off); if (lane + off < 64) suf += v; }
    int nx = __shfl_down(suf, 1); if (lane == 63) nx = 0;
    const bool hit = (suf >= need) && (nx < need);
    const unsigned long long mk = __ballot(hit);
    const int L = mk ? (int)__builtin_ctzll(mk) : 0;
    const int aboveL = __shfl(nx, L);
    const unsigned xw = hq[8 * L + ((lane & 15) >> 1)];
    int cj = (lane & 1) ? (int)(xw >> 16) : (int)(xw & 0xffffu); if (lane >= 16) cj = 0;
    int suf2 = cj;
#pragma unroll
    for (int off = 1; off < 16; off <<= 1) { const int v = __shfl_down(suf2, off); if (lane + off < 64) suf2 += v; }
    int nx2 = __shfl_down(suf2, 1); if (lane == 63) nx2 = 0;
    const int need2 = need - aboveL;
    const bool hit2 = (lane < 16) && (suf2 >= need2) && (nx2 < need2);
    const unsigned long long mk2 = __ballot(hit2);
    const int J = mk2 ? (int)__builtin_ctzll(mk2) : 0;
    bin = 16 * L + J; above = aboveL + __shfl(nx2, J); inbin = __shfl(cj, J);
}

__device__ __forceinline__ void radix_select4(const bf16_t* QI, const float* WI, const bf16_t* kib, int n, int qrow0, LAS unsigned* hist, LAS unsigned short* selb, int lane) {
    const int hf = lane >> 5, l31 = lane & 31;
    const unsigned lmask = (1u << l31) - 1u;
    bf16x8 A0, A1; float w0[8], w1[8];
    { const int r = l31, qq = 2 * ((r & 7) >> 2) + (r >> 4), hd = 4 * ((r >> 3) & 1) + (r & 3);
      const bf16_t* qp = QI + (size_t)(qrow0 + qq) * 256 + hd * 32 + 8 * hf;
      A0 = *(const bf16x8*)qp; A1 = *(const bf16x8*)(qp + 16);
      const float* wp0 = WI + (size_t)(qrow0 + 2 * hf) * 8;
#pragma unroll
      for (int e = 0; e < 8; ++e) { w0[e] = wp0[e]; w1[e] = wp0[8 + e]; } }
    unsigned pref0 = 0, pref1 = 0;
    int need0 = 256, need1 = 256;
#define SCORE_TILE(s0, k0v, k1v) do { const bf16_t* kp_ = kib + (size_t)((s0) + l31) * 32 + 8 * hf; \
        f32x16 ac_ = {0.f,0.f,0.f,0.f,0.f,0.f,0.f,0.f,0.f,0.f,0.f,0.f,0.f,0.f,0.f,0.f}; \
        ac_ = MFMA32(A0, *(const bf16x8*)kp_, ac_); ac_ = MFMA32(A1, *(const bf16x8*)(kp_ + 16), ac_); \
        float sa_ = 0.f, sb_ = 0.f; \
        _Pragma("unroll") for (int e_ = 0; e_ < 8; ++e_) { sa_ = fmaf(w0[e_], fmaxf(ac_[e_], 0.f), sa_); sb_ = fmaf(w1[e_], fmaxf(ac_[8 + e_], 0.f), sb_); } \
        const unsigned ua_ = __float_as_uint(sa_), ub_ = __float_as_uint(sb_); \
        k0v = (ua_ & 0x80000000u) ? ~ua_ : (ua_ | 0x80000000u); k1v = (ub_ & 0x80000000u) ? ~ub_ : (ub_ | 0x80000000u); } while (0)
#pragma unroll 1
    for (int pass = 0; pass < 3; ++pass) {
        { u32x4 z = (u32x4){0u, 0u, 0u, 0u};
#pragma unroll
          for (int i = 0; i < 16; ++i) *(LAS u32x4*)(hist + 4 * (lane + 64 * i)) = z; }
        const int shp = (pass == 0) ? 21 : (pass == 1 ? 10 : 0);
        const unsigned bmask = (pass == 2) ? 1023u : 2047u;
        const int shm = (pass == 0) ? 31 : (pass == 1 ? 21 : 10);
        for (int s0 = 0; s0 < n; s0 += 32) {
            unsigned k0, k1; SCORE_TILE(s0, k0, k1);
            const bool m0 = (pass == 0) || ((k0 >> shm) == pref0), m1 = (pass == 0) || ((k1 >> shm) == pref1);
            if (m0) { const unsigned bin = (k0 >> shp) & bmask; __hip_atomic_fetch_add(hist + (2 * hf) * 1024 + (bin >> 1), 1u << (16 * (bin & 1)), __ATOMIC_RELAXED, __HIP_MEMORY_SCOPE_WORKGROUP); }
            if (m1) { const unsigned bin = (k1 >> shp) & bmask; __hip_atomic_fetch_add(hist + (2 * hf + 1) * 1024 + (bin >> 1), 1u << (16 * (bin & 1)), __ATOMIC_RELAXED, __HIP_MEMORY_SCOPE_WORKGROUP); }
        }
        int bins[4], abv[4];
#pragma unroll
        for (int qq = 0; qq < 4; ++qq) {
            const int nd = __shfl((qq & 1) ? need1 : need0, (qq >> 1) * 32);
            scan_hist(hist + qq * 1024, nd, lane, bins[qq], abv[qq]);
        }
        const int b0 = hf ? bins[2] : bins[0], b1 = hf ? bins[3] : bins[1], a0 = hf ? abv[2] : abv[0], a1 = hf ? abv[3] : abv[1];
        if (pass == 0) { pref0 = (unsigned)b0; pref1 = (unsigned)b1; }
        else if (pass == 1) { pref0 = (pref0 << 11) | (unsigned)b0; pref1 = (pref1 << 11) | (unsigned)b1; }
        else { pref0 = (pref0 << 10) | (unsigned)b0; pref1 = (pref1 << 10) | (unsigned)b1; }
        need0 -= a0; need1 -= a1;
    }
    int cnt0 = 0, cnt1 = 0, tie0 = 0, tie1 = 0;
    for (int s0 = 0; s0 < n; s0 += 32) {
        unsigned k0, k1; SCORE_TILE(s0, k0, k1);
        {
            const bool eq = (k0 == pref0); const unsigned long long bt = __ballot(eq); const unsigned hb = hf ? (unsigned)(bt >> 32) : (unsigned)bt;
            const bool take = (k0 > pref0) || (eq && (tie0 + (int)__popc(hb & lmask) < need0)); tie0 += (int)__popc(hb);
            const unsigned long long bs = __ballot(take); const unsigned hs = hf ? (unsigned)(bs >> 32) : (unsigned)bs;
            const int pos = cnt0 + (int)__popc(hs & lmask); cnt0 += (int)__popc(hs);
            if (take && pos < 256) selb[(2 * hf) * 256 + pos] = (unsigned short)(s0 + l31);
        }
        {
            const bool eq = (k1 == pref1); const unsigned long long bt = __ballot(eq); const unsigned hb = hf ? (unsigned)(bt >> 32) : (unsigned)bt;
            const bool take = (k1 > pref1) || (eq && (tie1 + (int)__popc(hb & lmask) < need1)); tie1 += (int)__popc(hb);
            const unsigned long long bs = __ballot(take); const unsigned hs = hf ? (unsigned)(bs >> 32) : (unsigned)bs;
            const int pos = cnt1 + (int)__popc(hs & lmask); cnt1 += (int)__popc(hs);
            if (take && pos < 256) selb[(2 * hf + 1) * 256 + pos] = (unsigned short)(s0 + l31);
        }
    }
#undef SCORE_TILE
}

#define XB_TMO      128
#define XB_XCNT(j)  (256  + 64 * (j))
#define XB_XSUB(j)  (1280 + 64 * (j))
#define XB_XGEN(j)  (2304 + 64 * (j))
#define XB_TOP      3328
#define XB_TOPGEN   3392
#define XCD_BAR_WORDS 3456
#define XB_SPIN_CAP (1u << 18)

__device__ __forceinline__ unsigned xb_ld(unsigned* p)              { return __hip_atomic_load(p, __ATOMIC_RELAXED, __HIP_MEMORY_SCOPE_AGENT); }
__device__ __forceinline__ unsigned xb_add(unsigned* p, unsigned v) { return __hip_atomic_fetch_add(p, v, __ATOMIC_RELAXED, __HIP_MEMORY_SCOPE_AGENT); }
__device__ __forceinline__ unsigned xb_xcc_id() { return (unsigned)__builtin_amdgcn_s_getreg((3 << 11) | 20) & 0xFu; }
#define XB_SPIN(cond, bar) do { unsigned _sp = 0; while (cond) { __builtin_amdgcn_s_sleep(1); \
    if ((++_sp & 255u) == 0u) { if (xb_ld(&(bar)[XB_TMO])) break; if (_sp > XB_SPIN_CAP) { atomicAdd(&(bar)[XB_TMO], 1u); break; } } } } while (0)

struct XcdBarrier {
    unsigned* bar; unsigned x;
    volatile unsigned* st;
};

__device__ __forceinline__ XcdBarrier xcd_barrier_post(unsigned* bar, volatile unsigned* st) {
    XcdBarrier b; b.bar = bar; b.x = xb_xcc_id(); b.st = st;
    if (threadIdx.x == 0) (void)xb_add(&bar[XB_XCNT(b.x)], 1u);
    return b;
}
__device__ __forceinline__ void xcd_barrier_complete(unsigned* bar, unsigned x, unsigned& nloc, unsigned& nx) {
    const unsigned G = gridDim.x * gridDim.y * gridDim.z;
    unsigned sum, cnt, mine, sp = 0u;
    for (;;) {
        sum = 0u; cnt = 0u; mine = 0u;
#pragma unroll
        for (unsigned j = 0; j < 16; ++j) { const unsigned c = xb_ld(&bar[XB_XCNT(j)]); sum += c; cnt += (c > 0u) ? 1u : 0u; mine = (j == x) ? c : mine; }
        if (sum == G) break;
        __builtin_amdgcn_s_sleep(1);
        if ((++sp & 255u) == 0u) { if (xb_ld(&bar[XB_TMO])) break; if (sp > XB_SPIN_CAP) { atomicAdd(&bar[XB_TMO], 1u); break; } }
    }
    nloc = mine > 0u ? mine : 1u; nx = cnt > 0u ? cnt : 1u;
}

__device__ __forceinline__ void xcd_barrier(const XcdBarrier& b) {
    asm volatile("s_waitcnt vmcnt(0)" ::: "memory");
    __syncthreads();
    if (threadIdx.x == 0) {
        unsigned* bar = b.bar;
        __builtin_amdgcn_s_waitcnt(0);
        unsigned nloc = b.st[0], nx = b.st[1];
        if (nloc == 0u) { xcd_barrier_complete(bar, b.x, nloc, nx); b.st[0] = nloc; b.st[1] = nx; }
        const unsigned old = xb_add(&bar[XB_XSUB(b.x)], 1u);
        const unsigned gen = old / nloc;
        if (old + 1u == (gen + 1u) * nloc) {
            __builtin_amdgcn_fence(__ATOMIC_RELEASE, "agent");
            asm volatile("s_waitcnt vmcnt(0)" ::: "memory");
            const unsigned og = xb_add(&bar[XB_TOP], 1u);
            const unsigned tg = og / nx;
            if (og + 1u == (tg + 1u) * nx) xb_add(&bar[XB_TOPGEN], 1u);
            else XB_SPIN(xb_ld(&bar[XB_TOPGEN]) == tg, bar);
            __builtin_amdgcn_fence(__ATOMIC_ACQUIRE, "agent");
            xb_add(&bar[XB_XGEN(b.x)], 1u);
            asm volatile("s_waitcnt vmcnt(0)" ::: "memory");
        } else {
            XB_SPIN(xb_ld(&bar[XB_XGEN(b.x)]) == gen, bar);
            __builtin_amdgcn_fence(__ATOMIC_ACQUIRE, "agent");
            asm volatile("s_waitcnt vmcnt(0)" ::: "memory");
        }
    }
    __syncthreads();
}

__global__ void __launch_bounds__(512, 2) fwd_kernel(Args a) {
    extern __shared__ __attribute__((aligned(16))) unsigned char lds_raw[];
    LAS unsigned char* lds = (LAS unsigned char*)lds_raw;
    cg::grid_group grid = cg::this_grid();
    const int tid = threadIdx.x, lane = tid & 63, wave = __builtin_amdgcn_readfirstlane(tid >> 6);
    const int G = gridDim.x, gw = blockIdx.x * 8 + wave, NGW = G * 8;
    unsigned char* ws = a.ws; float* out = a.out;
    const float *x_prompt = a.in[0], *x_sample = a.in[1], *mem_prompt = a.in[2], *cache_a_k = a.in[3], *cache_a_v = a.in[4], *cache_idx_k = a.in[5], *cache_pool = a.in[6],
                *cache_mem_k = a.in[7], *cache_mem_v = a.in[8], *g_mix = a.in[9], *w_in = a.in[10], *g_qa = a.in[11], *g_ka = a.in[12], *g_kidx = a.in[13], *g_qm = a.in[14],
                *g_mem = a.in[15], *w_mem_kv = a.in[16], *g_km = a.in[17], *w_pool = a.in[18], *s_pool = a.in[19], *w_oa = a.in[20], *w_ob = a.in[21], *w_om = a.in[22],
                *w_out = a.in[23], *g_ffn = a.in[24], *w_gate = a.in[25], *w_up = a.in[26], *w_down = a.in[27];
    bf16_t *WIN = (bf16_t*)(ws + WS_WIN), *WMEM = (bf16_t*)(ws + WS_WMEM), *WPOOL = (bf16_t*)(ws + WS_WPOOL), *WOA = (bf16_t*)(ws + WS_WOA), *WOB = (bf16_t*)(ws + WS_WOB),
           *WOM = (bf16_t*)(ws + WS_WOM), *WOUT = (bf16_t*)(ws + WS_WOUT), *WGU = (bf16_t*)(ws + WS_WGU), *WDN = (bf16_t*)(ws + WS_WDN), *MEMN = (bf16_t*)(ws + WS_MEMN),
           *KVMEM = (bf16_t*)(ws + WS_KVMEM), *MKB = (bf16_t*)(ws + WS_MKB), *MVT = (bf16_t*)(ws + WS_MVT), *KVS = (bf16_t*)(ws + WS_KVS), *KIS = (bf16_t*)(ws + WS_KIS),
           *KI = (bf16_t*)(ws + WS_KI), *H = (bf16_t*)(ws + WS_H), *QA = (bf16_t*)(ws + WS_QA), *KV = (bf16_t*)(ws + WS_KV), *QI = (bf16_t*)(ws + WS_QI),
           *UB = (bf16_t*)(ws + WS_UB), *QM = (bf16_t*)(ws + WS_QM), *PP = (bf16_t*)(ws + WS_PP), *GT = (bf16_t*)(ws + WS_G);
    float *WI = (float*)(ws + WS_WI), *KW32 = (float*)(ws + WS_KW32);
    unsigned char *KV8 = ws + WS_KV8, *QA8 = ws + WS_QA8, *KVS8 = ws + WS_KVS8;
    bf16_t* QL = (bf16_t*)(ws + WS_QL); bf16_t* WDN2 = (bf16_t*)(ws + WS_WDN2); float* PART = (float*)(ws + WS_QA);
    unsigned* ctl = (unsigned*)(ws + WS_CTL);
    bf16_t *ABR = H, *MBR = H + (size_t)MT * 512;
    float* Y = out + O_Y;
    volatile unsigned* xst = ctl + 8192 + 2 * blockIdx.x;
    __syncthreads();

    {
        if (blockIdx.x == 0) { for (int i = tid; i < 16384 / 4; i += 512) ((u32x4*)ctl)[i] = (u32x4){0u, 0u, 0u, 0u}; }
        LAS float* scr = (LAS float*)(lds + wave * 16384);
        for (int it = gw; it < 8704; it += NGW) {
            int r = it; const float* W; int K, N, destN; bf16_t* WT; int kind;
            if (r < 2688) { kind = 0; W = w_in; K = 1024; N = 5160; destN = NIN; WT = WIN; }
            else if ((r -= 2688) < 512) { kind = 1; W = w_mem_kv; K = 1024; N = 1024; destN = 1024; WT = WMEM; }
            else if ((r -= 512) < 256) { kind = 1; W = w_oa; K = 512; N = 1024; destN = 1024; WT = WOA; }
            else if ((r -= 256) < 256) { kind = 1; W = w_ob; K = 512; N = 1024; destN = 1024; WT = WOB; }
            else if ((r -= 256) < 256) { kind = 1; W = w_om; K = 512; N = 1024; destN = 1024; WT = WOM; }
            else if ((r -= 256) < 512) { kind = 1; W = w_out; K = 1024; N = 1024; destN = 1024; WT = WOUT; }
            else if ((r -= 512) < 2816) { kind = 2; W = w_gate; K = 1024; N = DFF; destN = NGU; WT = WGU; }
            else { r -= 2816; kind = 1; W = w_down; K = DFF; N = 1024; destN = 1024; WT = WDN; }
            const int nblk = destN / 32, kb = r / nblk, nb = r % nblk, n = nb * 32 + (lane & 31);
            int col = n;
            if (kind == 0) col = map_in(n);
            else if (kind == 2) { const int j = n >> 8, rr = n & 255; if (rr >= 128) W = w_up; col = 128 * j + (rr & 127); }
            transpose_item(W, N, K, WT, kb * 64, nb * 32, col, scr, lane, kind == 2 ? g_ffn : nullptr);
        }
        for (int it = gw; it < 1408; it += NGW) {
            const int ks = it >> 7, rr = it & 127, kb = rr >> 5, nb = rr & 31;
            transpose_item(w_down + (size_t)ks * 256 * 1024, 1024, 256, WDN2 + (size_t)ks * 1024 * 256, kb * 64, nb * 32, nb * 32 + (lane & 31), scr, lane);
        }
        for (int idx = gw * 64 + lane; idx < 512 * 256; idx += NGW * 64) {
            const int n = idx >> 8, kk = idx & 255, g = n >> 7, e = n & 127;
            const float v = ((kk >> 7) == (g & 1)) ? w_pool[(size_t)(g * 128 + (kk & 127)) * 128 + e] : 0.f;
            WPOOL[idx] = (bf16_t)(cvt_pk_bf16(v, 0.f) & 0xffffu);
        }
        {
            f32x4 gg[4];
#pragma unroll
            for (int j = 0; j < 4; ++j) gg[j] = ((const f32x4*)g_mix)[lane + 64 * j];
            f32x4 va[4], vb[4], na[4], nb[4];
            int r = gw;
#define XROW(rr_) ((rr_) < MP ? x_prompt + (size_t)(rr_) * 1024 : x_sample + (size_t)((rr_) - MP) * 1024)
            if (r < MT) { const float* xa = XROW(r); const int r1 = r + NGW; const float* xb = r1 < MT ? XROW(r1) : xa;
#pragma unroll
                for (int j = 0; j < 4; ++j) { va[j] = ((const f32x4*)xa)[lane + 64 * j]; vb[j] = ((const f32x4*)xb)[lane + 64 * j]; } }
            for (; r < MT; r += 2 * NGW) {
                const int r1 = r + NGW; const bool has1 = r1 < MT;
                const int rn = r + 2 * NGW;
                if (rn < MT) { const float* xa = XROW(rn); const int rn1 = rn + NGW; const float* xb = rn1 < MT ? XROW(rn1) : xa;
#pragma unroll
                    for (int j = 0; j < 4; ++j) { na[j] = ((const f32x4*)xa)[lane + 64 * j]; nb[j] = ((const f32x4*)xb)[lane + 64 * j]; } }
                float sa = 0.f, sb = 0.f;
#pragma unroll
                for (int j = 0; j < 4; ++j) { sa += (va[j].x * va[j].x + va[j].y * va[j].y) + (va[j].z * va[j].z + va[j].w * va[j].w); sb += (vb[j].x * vb[j].x + vb[j].y * vb[j].y) + (vb[j].z * vb[j].z + vb[j].w * vb[j].w); }
                const float ra = rsqrtf(wave_sum(sa) * (1.f / 1024.f) + EPS), rb = rsqrtf(wave_sum(sb) * (1.f / 1024.f) + EPS);
#pragma unroll
                for (int j = 0; j < 4; ++j) {
                    u32x2 w; w.x = cvt_pk_bf16(va[j].x * ra * gg[j].x, va[j].y * ra * gg[j].y); w.y = cvt_pk_bf16(va[j].z * ra * gg[j].z, va[j].w * ra * gg[j].w);
                    *(u32x2*)(H + (size_t)r * 1024 + 4 * lane + 256 * j) = w;
                    if (has1) { u32x2 w2; w2.x = cvt_pk_bf16(vb[j].x * rb * gg[j].x, vb[j].y * rb * gg[j].y); w2.y = cvt_pk_bf16(vb[j].z * rb * gg[j].z, vb[j].w * rb * gg[j].w);
                        *(u32x2*)(H + (size_t)r1 * 1024 + 4 * lane + 256 * j) = w2; } }
#pragma unroll
                for (int j = 0; j < 4; ++j) { va[j] = na[j]; vb[j] = nb[j]; }
            }
#undef XROW
        }
        for (int r = gw; r < 2048; r += NGW) rms_row_1024(mem_prompt + (size_t)r * 1024, g_mem, MEMN + (size_t)r * 1024, lane);
        for (int r = gw; r < 16 * 1024; r += NGW) {
            const int b = r >> 10, s = r & 1023;
            const float* src = (lane < 32) ? cache_a_k + (size_t)r * 128 + 4 * lane : cache_a_v + (size_t)r * 128 + 4 * (lane - 32);
            const f32x4 v = *(const f32x4*)src; u32x2 w; w.x = cvt_pk_bf16(v.x, v.y); w.y = cvt_pk_bf16(v.z, v.w);
            { int f8 = __builtin_amdgcn_cvt_pk_fp8_f32(v.x, v.y, 0, false); f8 = __builtin_amdgcn_cvt_pk_fp8_f32(v.z, v.w, f8, true);
              *(unsigned*)(KVS8 + (size_t)(b * SKEYS + s) * 256 + 4 * lane) = (unsigned)f8; }
        }
        for (int idx = gw * 64 + lane; idx < 16 * 1024 * 16; idx += NGW * 64) {
            const int r = idx >> 4, c2 = idx & 15, b = r >> 10, s = r & 1023;
            const float v0 = cache_idx_k[(size_t)r * 32 + 2 * c2], v1 = cache_idx_k[(size_t)r * 32 + 2 * c2 + 1];
            *(unsigned*)(KIS + (size_t)(b * SKEYS + s) * 32 + 2 * c2) = cvt_pk_bf16(v0, v1);
        }
        for (int i0 = gw * 64 + lane; i0 < 16 * 256 * 256; i0 += 4 * NGW * 64) {
            f32x4 va[2]; float v0[4], v1[4];
#pragma unroll
            for (int j = 0; j < 4; ++j) { const int idx = i0 + j * NGW * 64; const bool ok = idx < 16 * 256 * 256; v0[j] = ok ? cache_mem_k[(size_t)idx * 2] : 0.f; v1[j] = ok ? cache_mem_k[(size_t)idx * 2 + 1] : 0.f; }
#pragma unroll
            for (int j = 0; j < 4; ++j) { const int idx = i0 + j * NGW * 64; if (idx < 16 * 256 * 256) *(unsigned*)(MKB + (size_t)2048 * 512 + (size_t)idx * 2) = cvt_pk_bf16(v0[j], v1[j]); }
            (void)va;
        }
        for (int it = gw; it < 16 * 8 * 8; it += NGW) {
            const int b = it >> 6, kb = (it >> 3) & 7, hb = it & 7;
            float tv[32];
#pragma unroll
            for (int k = 0; k < 32; ++k) tv[k] = cache_mem_v[((size_t)(b * 256 + kb * 32 + k)) * 512 + hb * 64 + lane];
#pragma unroll
            for (int k = 0; k < 32; ++k) scr[k * 65 + lane] = tv[k];
            asm volatile("s_waitcnt lgkmcnt(0)" ::: "memory");
#pragma unroll 4
            for (int h = 0; h < 64; h += 4) { const int hh = h + (lane >> 4), k2 = (lane & 15) * 2;
                const float a0 = scr[k2 * 65 + hh], a1 = scr[(k2 + 1) * 65 + hh];
                *(unsigned*)(MVT + ((size_t)(8 + b) * 512 + hb * 64 + hh) * 256 + kb * 32 + k2) = cvt_pk_bf16(a0, a1); }
            asm volatile("s_waitcnt lgkmcnt(0)" ::: "memory");
        }
    }
    grid.sync();
    const XcdBarrier xbar = xcd_barrier_post(ctl + 4096, xst);

    {
        pg8::StaticOrder S; S.init(MT, NIN, G, (int)blockIdx.x);
        pg8::Gemm g{H, WIN, MT, NIN, 1024, 1024, 1024, 0, nullptr, nullptr, nullptr, nullptr, 0};
        Epi<EP_INPROJ> E; E.p = EpiArgs{}; E.p.QA = QA; E.p.KV = KV; E.p.QI = QI; E.p.UB = UB; E.p.QM = QM; E.p.G = GT; E.p.KW32 = KW32;
        pg8::gemm_phase(lds, g, S, E);
        pg8::StaticOrder S2; S2.init(2048, 1024, G, (int)blockIdx.x >= G - 32 ? (int)blockIdx.x - (G - 32) : (1 << 20));
        pg8::Gemm g2{MEMN, WMEM, 2048, 1024, 1024, 1024, 1024, 0, nullptr, nullptr, nullptr, nullptr, 0};
        Epi<EP_BF16> E2; E2.p = EpiArgs{}; E2.p.O = KVMEM; E2.p.ldc = 1024; E2.p.cs = nullptr;
        pg8::gemm_phase(lds, g2, S2, E2);
    }
    xcd_barrier(xbar);

    float inv64[8], inv16q[4];
    {
        const int j8h = lane & 7;
#pragma unroll
        for (int e = 0; e < 8; ++e) inv64[e] = powf(10000.0f, -(float)(8 * (j8h & 3) + e) * (1.0f / 32.0f));
#pragma unroll
        for (int e = 0; e < 4; ++e) inv16q[e] = powf(10000.0f, -(float)(4 * (j8h & 3) + e) * (1.0f / 16.0f));
    }
    const float inv16k = powf(10000.0f, -(float)(lane & 15) * (1.0f / 16.0f));
    float gqa_[8], gka_[8], gqm_[8];
#pragma unroll
    for (int e = 0; e < 8; ++e) { gqa_[e] = g_qa[8 * (lane & 7) + e]; gka_[e] = g_ka[8 * (lane & 7) + e]; gqm_[e] = g_qm[8 * (lane & 15) + e]; }
    const float gkidx_ = g_kidx[lane & 31];
    for (int row = gw; row < MT; row += NGW) {
        const bool samp = row >= MP; const int rs = row - MP;
        int b, t, pos; if (!samp) { b = row >> 13; t = row & 8191; pos = t; } else { b = rs >> 6; t = rs & 63; pos = 1024 + t; }
        const float fpos = (float)pos;
        const int j8 = lane & 7;
        const u32x4 qa_raw = *(const u32x4*)(QA + (size_t)row * 512 + 8 * lane);
        u32x4 kv_raw = (u32x4){0u, 0u, 0u, 0u}; if (lane < 32) kv_raw = *(const u32x4*)(KV + (size_t)row * 256 + 8 * lane);
        const u32x2 qi_raw = *(const u32x2*)(QI + (size_t)row * 256 + 4 * lane);
        const float kw_x = KW32[(size_t)row * 64 + lane];
        const u32x4 qm_raw = *(const u32x4*)(QM + (size_t)row * 512 + 8 * lane);
        const int pw_ = 2 << (lane >> 4);
        u32x4 ubr[16];
#pragma unroll
        for (int k = 0; k < 16; ++k) { ubr[k] = (u32x4){0u, 0u, 0u, 0u}; if (k < pw_ && t - k >= 0) ubr[k] = *(const u32x4*)(UB + (size_t)(row - k) * 512 + 8 * lane); }
        float c64[8], s64[8];
#pragma unroll
        for (int e = 0; e < 8; ++e) sincos_red(fpos * inv64[e], s64[e], c64[e]);
        {
            float v[8]; unpack8(qa_raw, v);
            float ss = 0.f;
#pragma unroll
            for (int e = 0; e < 8; ++e) ss += v[e] * v[e];
            ss += __shfl_xor(ss, 1); ss += __shfl_xor(ss, 2); ss += __shfl_xor(ss, 4);
            const float rstd = rsqrtf(ss * (1.f / 64.f) + EPS);
            float o[8];
#pragma unroll
            for (int e = 0; e < 8; ++e) { v[e] = v[e] * rstd * gqa_[e]; }
#pragma unroll
            for (int e = 0; e < 8; ++e) { const float pv = __shfl_xor(v[e], 4); o[e] = (j8 < 4) ? v[e] * c64[e] - pv * s64[e] : v[e] * c64[e] + pv * s64[e]; }
            *(u32x2*)(QA8 + (size_t)row * 512 + 8 * lane) = pack8_fp8(o);
        }
        {
            float v[8]; unpack8(kv_raw, v);
            float ss = 0.f;
#pragma unroll
            for (int e = 0; e < 8; ++e) ss += v[e] * v[e];
            ss += __shfl_xor(ss, 1); ss += __shfl_xor(ss, 2); ss += __shfl_xor(ss, 4);
            const float rstd = rsqrtf(ss * (1.f / 64.f) + EPS);
            float kn[8], o[8];
#pragma unroll
            for (int e = 0; e < 8; ++e) kn[e] = v[e] * rstd * gka_[e];
#pragma unroll
            for (int e = 0; e < 8; ++e) { const float pv = __shfl_xor(kn[e], 4); o[e] = (j8 < 4) ? kn[e] * c64[e] - pv * s64[e] : kn[e] * c64[e] + pv * s64[e]; }
            float* ok = samp ? out + O_AKS + (size_t)rs * 128 : out + O_AKP + (size_t)row * 128;
            float* ov = samp ? out + O_AVS + (size_t)rs * 128 : out + O_AVP + (size_t)row * 128;
            if (lane < 16) {
                { const u32x2 w8 = pack8_fp8(o); *(u32x2*)(KV8 + (size_t)row * 256 + 8 * lane) = w8; if (samp) *(u32x2*)(KVS8 + (size_t)(b * SKEYS + 1024 + t) * 256 + 8 * lane) = w8; }
                *(f32x4*)(ok + 8 * lane) = (f32x4){o[0], o[1], o[2], o[3]}; *(f32x4*)(ok + 8 * lane + 4) = (f32x4){o[4], o[5], o[6], o[7]};
            } else if (lane < 32) {
                { const u32x2 w8 = pack8_fp8(v); *(u32x2*)(KV8 + (size_t)row * 256 + 8 * lane) = w8; if (samp) *(u32x2*)(KVS8 + (size_t)(b * SKEYS + 1024 + t) * 256 + 8 * lane) = w8; }
                *(f32x4*)(ov + 8 * (lane - 16)) = (f32x4){v[0], v[1], v[2], v[3]}; *(f32x4*)(ov + 8 * (lane - 16) + 4) = (f32x4){v[4], v[5], v[6], v[7]};
            }
        }
        {
            const u32x2 qv = qi_raw;
            float v[4] = {bflo(qv.x), bfhi(qv.x), bflo(qv.y), bfhi(qv.y)}, o[4];
#pragma unroll
            for (int e = 0; e < 4; ++e) { float sn, cs; sincos_red(fpos * inv16q[e], sn, cs);
                const float pv = __shfl_xor(v[e], 4); o[e] = (j8 < 4) ? v[e] * cs - pv * sn : v[e] * cs + pv * sn; }
            u32x2 w; w.x = cvt_pk_bf16(o[0], o[1]); w.y = cvt_pk_bf16(o[2], o[3]);
            *(u32x2*)(QI + (size_t)row * 256 + 4 * lane) = w;
            {
                const float wh = __shfl(kw_x, 32 + (lane >> 3)) * (0.0625f * 0.5f);
                float ql[4] = {wh * bflo(w.x), wh * bfhi(w.x), wh * bflo(w.y), wh * bfhi(w.y)};
#pragma unroll
                for (int off = 8; off < 64; off <<= 1) {
#pragma unroll
                    for (int e = 0; e < 4; ++e) ql[e] += __shfl_xor(ql[e], off); }
                if (lane < 8) { u32x2 wq; wq.x = cvt_pk_bf16(ql[0], ql[1]); wq.y = cvt_pk_bf16(ql[2], ql[3]); *(u32x2*)(QL + (size_t)row * 32 + 4 * lane) = wq; }
            }
        }
        {
            const float x = kw_x;
            float ss = (lane < 32) ? x * x : 0.f;
            ss += __shfl_xor(ss, 1); ss += __shfl_xor(ss, 2); ss += __shfl_xor(ss, 4); ss += __shfl_xor(ss, 8); ss += __shfl_xor(ss, 16);
            const float rstd = rsqrtf(ss * (1.f / 32.f) + EPS);
            const float yv = x * rstd * gkidx_;
            float sn, cs; sincos_red(fpos * inv16k, sn, cs);
            const float pv = __shfl_xor(yv, 16);
            const float o = ((lane & 31) < 16) ? yv * cs - pv * sn : yv * cs + pv * sn;
            const unsigned ob = cvt_pk_bf16(o, 0.f) & 0xffffu;
            if (lane < 32) {
                KI[(size_t)row * 32 + lane] = (bf16_t)ob;
                if (samp) { KIS[(size_t)(b * SKEYS + 1024 + t) * 32 + lane] = (bf16_t)ob; out[O_IKS + (size_t)rs * 32 + lane] = o; }
                else out[O_IKP + (size_t)row * 32 + lane] = o;
            } else if (lane < 40) WI[(size_t)row * 8 + (lane - 32)] = x * 0.0625f;
        }
        {
            float v[8]; unpack8(qm_raw, v);
            float ss = 0.f;
#pragma unroll
            for (int e = 0; e < 8; ++e) ss += v[e] * v[e];
            ss += __shfl_xor(ss, 1); ss += __shfl_xor(ss, 2); ss += __shfl_xor(ss, 4); ss += __shfl_xor(ss, 8);
            const float rstd = rsqrtf(ss * (1.f / 128.f) + EPS);
#pragma unroll
            for (int e = 0; e < 8; ++e) v[e] = v[e] * rstd * gqm_[e];
            *(u32x4*)(QM + (size_t)row * 512 + 8 * lane) = pack8(v);
        }
        {
            const int c0 = 8 * lane, gi = lane >> 4, w = 2 << gi;
            float u[8], sum[8];
            unpack8(ubr[0], u);
#pragma unroll
            for (int e = 0; e < 8; ++e) sum[e] = u[e];
#pragma unroll
            for (int k = 1; k < 16; ++k) { float x[8]; unpack8(ubr[k], x);
#pragma unroll
                for (int e = 0; e < 8; ++e) sum[e] += x[e]; }
            if (samp && t < 15) {
                for (int k = 1; k < 16; ++k) {
                    const int tt = t - k;
                    if (k < w && tt < 0) { const float* cp = cache_pool + (size_t)(b * 15 + 15 + tt) * 512 + c0; const f32x4 x0 = *(const f32x4*)cp, x1 = *(const f32x4*)(cp + 4);
                        sum[0] += x0.x; sum[1] += x0.y; sum[2] += x0.z; sum[3] += x0.w; sum[4] += x1.x; sum[5] += x1.y; sum[6] += x1.z; sum[7] += x1.w; }
                }
            }
            const int cnt = samp ? w : (w < t + 1 ? w : t + 1);
            const float ic = 1.0f / (float)cnt;
            float o[8];
#pragma unroll
            for (int e = 0; e < 8; ++e) o[e] = sum[e] * ic - u[e];
            *(u32x4*)(PP + (size_t)row * 512 + c0) = pack8(o);
            float* po = nullptr;
            if (!samp && t >= 8177) po = out + O_PLP + (size_t)(b * 15 + (t - 8177)) * 512 + c0;
            if (samp && t >= 49) po = out + O_PLS + (size_t)(b * 15 + (t - 49)) * 512 + c0;
            if (po) { *(f32x4*)po = (f32x4){u[0], u[1], u[2], u[3]}; *(f32x4*)(po + 4) = (f32x4){u[4], u[5], u[6], u[7]}; }
        }
    }
    for (int r = gw; r < 2048; r += NGW) {
        float v[8]; unpack8(*(const u32x4*)(KVMEM + (size_t)r * 1024 + 8 * lane), v);
        float ss = 0.f;
#pragma unroll
        for (int e = 0; e < 8; ++e) ss += v[e] * v[e];
        ss += __shfl_xor(ss, 1); ss += __shfl_xor(ss, 2); ss += __shfl_xor(ss, 4); ss += __shfl_xor(ss, 8);
        const float rstd = rsqrtf(ss * (1.f / 128.f) + EPS);
#pragma unroll
        for (int e = 0; e < 8; ++e) v[e] = v[e] * rstd * g_km[8 * (lane & 15) + e];
        *(u32x4*)(MKB + (size_t)r * 512 + 8 * lane) = pack8(v);
        float* mk = out + O_MKP + (size_t)r * 512 + 8 * lane;
        *(f32x4*)mk = (f32x4){v[0], v[1], v[2], v[3]}; *(f32x4*)(mk + 4) = (f32x4){v[4], v[5], v[6], v[7]};
        float x[8]; const u32x4 xr = *(const u32x4*)(KVMEM + (size_t)r * 1024 + 512 + 8 * lane); unpack8(xr, x);
        float* mv = out + O_MVP + (size_t)r * 512 + 8 * lane;
        *(f32x4*)mv = (f32x4){x[0], x[1], x[2], x[3]}; *(f32x4*)(mv + 4) = (f32x4){x[4], x[5], x[6], x[7]};
        const int b = r >> 8, key = r & 255; const unsigned xs[4] = {xr.x, xr.y, xr.z, xr.w};
#pragma unroll
        for (int e = 0; e < 8; ++e) MVT[((size_t)b * 512 + 8 * lane + e) * 256 + key] = (bf16_t)((e & 1) ? (xs[e >> 1] >> 16) : (xs[e >> 1] & 0xffffu));
    }
    xcd_barrier(xbar);

    {
        pg8::StaticOrder S; S.init(MT, 512, G, (int)blockIdx.x);
        pg8::Gemm g{PP, WPOOL, MT, 512, 256, 512, 256, 256, nullptr, nullptr, nullptr, nullptr, 0};
        Epi<EP_BF16> E; E.p = EpiArgs{}; E.p.O = UB; E.p.ldc = 512; E.p.cs = s_pool;
        pg8::gemm_phase(lds, g, S, E);
    }
    {
        LAS unsigned* hist = (LAS unsigned*)(lds + wave * 20480);
        LAS unsigned short* selb = (LAS unsigned short*)(lds + wave * 20480);
        LAS unsigned* candk = (LAS unsigned*)(lds + wave * 20480 + 4096);
        LAS unsigned short* candi = (LAS unsigned short*)(lds + wave * 20480 + 6144);
        LAS unsigned char* wbuf = lds + wave * 20480 + 4096;
        const int hf = lane >> 5, l31 = lane & 31;
        const unsigned lmask = (1u << l31) - 1u;
        const int myq = (int)(__builtin_amdgcn_s_getreg((3 << 11) | 20) & 7u);
#pragma unroll 1
        for (int kq = 0; kq < 8; ++kq) {
        const int qb = (myq + kq) & 7;
        for (;;) {
            int item = 0; if (lane == 0) item = (int)atomicAdd(ctl + 64 + 64 * qb, 1u);
            item = __builtin_amdgcn_readfirstlane(item);
            if (item >= 1040) break;
            int n, qrow0; const bf16_t *kib, *kvb; const unsigned char* kv8;
            if (item < 1024) { const int c = 127 - (item >> 3), sg = item & 7;
                n = 64 * (c + 1); qrow0 = qb * 8192 + c * 64 + sg * 8; kib = KI + (size_t)qb * 8192 * 32; kvb = KV + (size_t)qb * 8192 * 256; kv8 = KV8 + (size_t)qb * 8192 * 256; }
            else { const int j = item - 1024, sb = 2 * qb + (j >> 3), sg = j & 7;
                n = SKEYS; qrow0 = MP + sb * 64 + sg * 8; kib = KIS + (size_t)sb * SKEYS * 32; kvb = KVS + (size_t)sb * SKEYS * 256; kv8 = KVS8 + (size_t)sb * SKEYS * 256; }
            const int ntile = (n < 256 ? n : 256) >> 4;
            bool fast = false;
            if (n <= 256) {
                for (int i = lane; i < 2048; i += 64) selb[i] = (unsigned short)(i & 255);
                fast = true;
            } else {
                bf16x8 A00, A01, A10, A11; float wa[8], wb[8], wc_[8], wd[8];
                { const int r = l31, qq = 2 * ((r & 7) >> 2) + (r >> 4), hd = 4 * ((r >> 3) & 1) + (r & 3);
                  const bf16_t* qp = QI + (size_t)(qrow0 + qq) * 256 + hd * 32 + 8 * hf;
                  A00 = *(const bf16x8*)qp; A01 = *(const bf16x8*)(qp + 16); A10 = *(const bf16x8*)(qp + 4 * 256); A11 = *(const bf16x8*)(qp + 4 * 256 + 16);
                  const float* wp0 = WI + (size_t)(qrow0 + 2 * hf) * 8;
#pragma unroll
                  for (int e = 0; e < 8; ++e) { wa[e] = 0.5f * wp0[e]; wb[e] = 0.5f * wp0[8 + e]; wc_[e] = 0.5f * wp0[32 + e]; wd[e] = 0.5f * wp0[40 + e]; } }
                bf16x8 AL0, AL1;
                { u32x4 z0 = (u32x4){0u, 0u, 0u, 0u}, z1 = z0;
                  if (l31 < 8) { const int rg = l31 & 3, hr = l31 >> 2, qq = rg < 2 ? 2 * hr + rg : 4 + 2 * hr + (rg - 2);
                      const bf16_t* lp = QL + (size_t)(qrow0 + qq) * 32 + 8 * hf; z0 = *(const u32x4*)lp; z1 = *(const u32x4*)(lp + 16); }
                  AL0 = __builtin_bit_cast(bf16x8, z0); AL1 = __builtin_bit_cast(bf16x8, z1); }
#define SCORE8(b0_, b1_, sa_, sb_, sc_, sd_) do { \
                    f32x16 ac_ = {0.f,0.f,0.f,0.f,0.f,0.f,0.f,0.f,0.f,0.f,0.f,0.f,0.f,0.f,0.f,0.f}, ad_ = ac_; \
                    f32x16 al_ = ac_; \
                    ac_ = MFMA32(A00, b0_, ac_); ad_ = MFMA32(A10, b0_, ad_); al_ = MFMA32(AL0, b0_, al_); ac_ = MFMA32(A01, b1_, ac_); ad_ = MFMA32(A11, b1_, ad_); al_ = MFMA32(AL1, b1_, al_); \
                    sa_ = al_[0]; sb_ = al_[1]; sc_ = al_[2]; sd_ = al_[3];     \
                    _Pragma("unroll") for (int e_ = 0; e_ < 8; ++e_) { sa_ = fmaf(wa[e_], fabsf(ac_[e_]), sa_); sb_ = fmaf(wb[e_], fabsf(ac_[8 + e_]), sb_); \
                                                                      sc_ = fmaf(wc_[e_], fabsf(ad_[e_]), sc_); sd_ = fmaf(wd[e_], fabsf(ad_[8 + e_]), sd_); } } while (0)
#define KLOAD(s_, r0_, r1_) do { const bf16_t* kp_ = kib + (size_t)((s_) + l31) * 32 + 8 * hf; r0_ = *(const bf16x8*)kp_; r1_ = *(const bf16x8*)(kp_ + 16); } while (0)
#define BINOF(s_, lo_, sc_) ((int)fminf(fmaxf(((s_) - (lo_)) * (sc_), 0.f), 1023.f))
                float lo0, lo1, lo2, lo3, bs0, bs1, bs2, bs3;
                {
                    bf16x8 b0, b1, c0, c1; KLOAD(0, b0, b1); KLOAD(32, c0, c1);
                    float s0, s1, s2, s3, t0, t1, t2, t3; SCORE8(b0, b1, s0, s1, s2, s3); SCORE8(c0, c1, t0, t1, t2, t3);
                    float mn0 = fminf(s0, t0), mn1 = fminf(s1, t1), mn2 = fminf(s2, t2), mn3 = fminf(s3, t3);
                    float mx0 = fmaxf(s0, t0), mx1 = fmaxf(s1, t1), mx2 = fmaxf(s2, t2), mx3 = fmaxf(s3, t3);
#pragma unroll
                    for (int o = 1; o < 32; o <<= 1) {
                        mn0 = fminf(mn0, __shfl_xor(mn0, o)); mn1 = fminf(mn1, __shfl_xor(mn1, o)); mn2 = fminf(mn2, __shfl_xor(mn2, o)); mn3 = fminf(mn3, __shfl_xor(mn3, o));
                        mx0 = fmaxf(mx0, __shfl_xor(mx0, o)); mx1 = fmaxf(mx1, __shfl_xor(mx1, o)); mx2 = fmaxf(mx2, __shfl_xor(mx2, o)); mx3 = fmaxf(mx3, __shfl_xor(mx3, o)); }
                    const float r0 = mx0 - mn0, r1 = mx1 - mn1, r2 = mx2 - mn2, r3 = mx3 - mn3;
                    lo0 = mn0 - 0.5f * r0; lo1 = mn1 - 0.5f * r1; lo2 = mn2 - 0.5f * r2; lo3 = mn3 - 0.5f * r3;
                    bs0 = r0 > 0.f ? 511.f / r0 : 0.f; bs1 = r1 > 0.f ? 511.f / r1 : 0.f; bs2 = r2 > 0.f ? 511.f / r2 : 0.f; bs3 = r3 > 0.f ? 511.f / r3 : 0.f;
                }
                { u32x4 z = (u32x4){0u, 0u, 0u, 0u};
#pragma unroll
                  for (int i = 0; i < 16; ++i) *(LAS u32x4*)(hist + 4 * (lane + 64 * i)) = z; }
                {
                    bf16x8 b0, b1; KLOAD(0, b0, b1);
                    for (int s0 = 0; s0 < n; s0 += 32) {
                        bf16x8 nb0, nb1; KLOAD((s0 + 32 < n) ? s0 + 32 : s0, nb0, nb1);
                        float s0_, s1_, s2_, s3_; SCORE8(b0, b1, s0_, s1_, s2_, s3_);
                        const int i0 = BINOF(s0_, lo0, bs0), i1 = BINOF(s1_, lo1, bs1), i2 = BINOF(s2_, lo2, bs2), i3 = BINOF(s3_, lo3, bs3);
                        __hip_atomic_fetch_add(hist + (2 * hf) * 512 + (i0 >> 1), 1u << (16 * (i0 & 1)), __ATOMIC_RELAXED, __HIP_MEMORY_SCOPE_WORKGROUP);
                        __hip_atomic_fetch_add(hist + (2 * hf + 1) * 512 + (i1 >> 1), 1u << (16 * (i1 & 1)), __ATOMIC_RELAXED, __HIP_MEMORY_SCOPE_WORKGROUP);
                        __hip_atomic_fetch_add(hist + (4 + 2 * hf) * 512 + (i2 >> 1), 1u << (16 * (i2 & 1)), __ATOMIC_RELAXED, __HIP_MEMORY_SCOPE_WORKGROUP);
                        __hip_atomic_fetch_add(hist + (5 + 2 * hf) * 512 + (i3 >> 1), 1u << (16 * (i3 & 1)), __ATOMIC_RELAXED, __HIP_MEMORY_SCOPE_WORKGROUP);
                        b0 = nb0; b1 = nb1;
                    }
                }
                int bins[8], abv[8], inb[8]; int worst = 0;
#pragma unroll
                for (int qq = 0; qq < 8; ++qq) { scan_hist1024(hist + qq * 512, 256, lane, bins[qq], abv[qq], inb[qq]); worst = inb[qq] > worst ? inb[qq] : worst; }
                fast = (worst <= 64);
                if (fast) {
                    const int B0 = hf ? bins[2] : bins[0], B1 = hf ? bins[3] : bins[1], B2 = hf ? bins[6] : bins[4], B3 = hf ? bins[7] : bins[5];
                    int c0 = 0, c1 = 0, c2 = 0, c3 = 0, d0 = 0, d1 = 0, d2 = 0, d3 = 0;
                    bf16x8 b0, b1; KLOAD(0, b0, b1);
                    for (int s0 = 0; s0 < n; s0 += 32) {
                        bf16x8 nb0, nb1; KLOAD((s0 + 32 < n) ? s0 + 32 : s0, nb0, nb1);
                        float s0_, s1_, s2_, s3_; SCORE8(b0, b1, s0_, s1_, s2_, s3_);
#define SELSTEP(sv_, lo_, bs_, Bq_, cq_, dq_, slot_) do { const int bi_ = BINOF(sv_, lo_, bs_); const bool tk_ = bi_ > Bq_, cd_ = bi_ == Bq_; \
                            const unsigned long long m1_ = __ballot(tk_), m2_ = __ballot(cd_); const unsigned h1_ = hf ? (unsigned)(m1_ >> 32) : (unsigned)m1_, h2_ = hf ? (unsigned)(m2_ >> 32) : (unsigned)m2_; \
                            const int p1_ = cq_ + (int)__popc(h1_ & lmask), p2_ = dq_ + (int)__popc(h2_ & lmask); cq_ += (int)__popc(h1_); dq_ += (int)__popc(h2_); \
                            if (tk_ && p1_ < 256) selb[(slot_) * 256 + p1_] = (unsigned short)(s0 + l31); \
                            if (cd_ && p2_ < 64) { const unsigned u_ = __float_as_uint(sv_); candk[(slot_) * 64 + p2_] = (u_ & 0x80000000u) ? ~u_ : (u_ | 0x80000000u); candi[(slot_) * 64 + p2_] = (unsigned short)(s0 + l31); } } while (0)
                        SELSTEP(s0_, lo0, bs0, B0, c0, d0, 2 * hf);
                        SELSTEP(s1_, lo1, bs1, B1, c1, d1, 2 * hf + 1);
                        SELSTEP(s2_, lo2, bs2, B2, c2, d2, 4 + 2 * hf);
                        SELSTEP(s3_, lo3, bs3, B3, c3, d3, 5 + 2 * hf);
#undef SELSTEP
                        b0 = nb0; b1 = nb1;
                    }
#pragma unroll
                    for (int qq = 0; qq < 8; ++qq) {
                        const int m = inb[qq], r = 256 - abv[qq];
                        const unsigned k = (lane < m) ? candk[qq * 64 + lane] : 0u; const int ix = (lane < m) ? (int)candi[qq * 64 + lane] : 0;
                        int rank = 0;
                        for (int j = 0; j < m; ++j) { const unsigned kj = (unsigned)__shfl((int)k, j); const int ij = __shfl(ix, j); rank += ((kj > k) || (kj == k && ij < ix)) ? 1 : 0; }
                        const bool tk = (lane < m) && (rank < r);
                        const unsigned long long mm = __ballot(tk);
                        const int pos = abv[qq] + (int)__popcll(mm & ((1ull << lane) - 1ull));
                        if (tk && pos < 256) selb[qq * 256 + pos] = (unsigned short)ix;
                    }
                }
#undef SCORE8
#undef KLOAD
#undef BINOF
            }
            if (fast) {
#pragma unroll 1
                for (int hq = 0; hq < 4; ++hq) sparse_attn_lds<2>(QA8, kv8, ABR, qrow0 + 2 * hq, selb + 2 * hq * 256, wbuf, ntile >> 1, lane);
            } else {
#pragma unroll 1
                for (int grp = 0; grp < 2; ++grp) {
                    radix_select4(QI, WI, kib, n, qrow0 + 4 * grp, hist, selb, lane);
#pragma unroll 1
                    for (int hq = 0; hq < 2; ++hq) sparse_attn_lds<2>(QA8, kv8, ABR, qrow0 + 4 * grp + 2 * hq, selb + 2 * hq * 256, wbuf, ntile >> 1, lane);
                }
            }
        }
        }
    }
    for (;;) {
        int it0 = 0; if (lane == 0) it0 = (int)atomicAdd(ctl + 32, 4u);
        it0 = __builtin_amdgcn_readfirstlane(it0);
        if (it0 >= (MT / 16) * 4) break;
#pragma unroll 1
        for (int j = 0; j < 4; ++j) { const int it = it0 + j; const int h = it & 3, r0 = (it >> 2) * 16;
            const int bb = r0 < MP ? (r0 >> 13) : 8 + ((r0 - MP) >> 6);
            mem_attn_item(QM, MKB + (size_t)bb * 256 * 512, MVT + ((size_t)bb * 512 + h * 128) * 256, MBR, r0, h, lane); }
    }
    xcd_barrier(xbar);
    {
        pg8::ChainOrder3 S; S.base.init(MT, 1024, G, (int)blockIdx.x);
        pg8::Gemm g{ABR, WOA, MT, 1024, 512, 512, 512, 0, UB, MBR, WOB, WOM, 0};
        Epi<EP_CHAIN> E; E.p = EpiArgs{}; E.p.G = GT;
        pg8::gemm_phase(lds, g, S, E);
    }
    xcd_barrier(xbar);
    {
        pg8::StaticOrder S; S.init(MT, 1024, G, (int)blockIdx.x);
        pg8::Gemm g{GT, WOUT, MT, 1024, 1024, 3072, 1024, 0, nullptr, nullptr, nullptr, nullptr, 0};
        Epi<EP_WOUT> E; E.p = EpiArgs{}; E.p.Y = Y; E.p.xp = x_prompt; E.p.xs = x_sample; E.p.XG = H; E.p.SS = KW32; E.p.gf = g_ffn;
        pg8::gemm_phase(lds, g, S, E);
    }
    xcd_barrier(xbar);
    {
        pg8::StaticOrder S; S.init(MT, NGU, G, (int)blockIdx.x);
        pg8::Gemm g{H, WGU, MT, NGU, 1024, 1024, 1024, 0, nullptr, nullptr, nullptr, nullptr, 0};
        Epi<EP_UP> E; E.p = EpiArgs{}; E.p.HID = GT; E.p.SS = KW32;
        pg8::gemm_phase(lds, g, S, E);
    }
    xcd_barrier(xbar);
    {
        pg8::StaticOrder S; S.init(MP, 1024, G, (int)blockIdx.x);
        pg8::Gemm g{GT, WDN, MP, 1024, DFF, DFF, DFF, 0, nullptr, nullptr, nullptr, nullptr, 0};
        Epi<EP_DOWN> E; E.p = EpiArgs{}; E.p.Y = Y; E.p.XG = H;
        pg8::gemm_phase(lds, g, S, E);
        pg8::StaticOrder S2; S2.init(MS, 11 * 1024, G, (int)blockIdx.x);
        pg8::Gemm g2{GT + (size_t)MP * DFF, WDN2, MS, 11 * 1024, 256, DFF, 256, 256, nullptr, nullptr, nullptr, nullptr, 2};
        Epi<EP_DOWN_PART> E2; E2.p = EpiArgs{}; E2.p.Y = PART;
        pg8::gemm_phase(lds, g2, S2, E2);
    }
    xcd_barrier(xbar);
    for (int i = (gw * 64 + lane) * 4; i < MS * 1024; i += NGW * 64 * 4) {
        const int r = i >> 10, cidx = i & 1023;
        const u32x2 xb = *(const u32x2*)(H + (size_t)(MP + r) * 1024 + cidx);
        f32x4 acc4 = (f32x4){bflo(xb.x), bfhi(xb.x), bflo(xb.y), bfhi(xb.y)};
#pragma unroll
        for (int ks = 0; ks < 11; ++ks) acc4 = acc4 + *(const f32x4*)(PART + ((size_t)ks * 1024 + r) * 1024 + cidx);
        *(f32x4*)(Y + (size_t)(MP + r) * 1024 + cidx) = acc4;
    }
}

extern "C" void kernel_launch(void* const* d_in, const int* in_sizes, int n_in, void* d_out, int out_size, void* d_ws, size_t ws_size, hipStream_t stream) {
    static int grid = 0;
    if (grid == 0) {
        if (n_in != 28 || ws_size < WS_END) { fprintf(stderr, "kernel_launch: unexpected inputs (n_in %d, ws %zu)\n", n_in, ws_size); grid = -1; return; }
        int dev = 0, cus = 0, per_cu = 0;
        (void)hipGetDevice(&dev);
        (void)hipDeviceGetAttribute(&cus, hipDeviceAttributeMultiprocessorCount, dev);
        (void)hipFuncSetAttribute((const void*)fwd_kernel, hipFuncAttributeMaxDynamicSharedMemorySize, LDS_BYTES);
        (void)hipOccupancyMaxActiveBlocksPerMultiprocessor(&per_cu, (const void*)fwd_kernel, 512, LDS_BYTES);
        if (per_cu < 1) per_cu = 1;
        grid = cus * per_cu;
    }
    if (grid < 0) return;
    Args a{};
    for (int i = 0; i < 28; ++i) a.in[i] = (const float*)d_in[i];
    a.out = (float*)d_out; a.ws = (unsigned char*)d_ws;
    void* args[] = {&a};
    hipError_t e = hipLaunchCooperativeKernel((const void*)fwd_kernel, dim3(grid), dim3(512), args, LDS_BYTES, stream);
    if (e != hipSuccess) fprintf(stderr, "cooperative launch failed: %s (grid %d)\n", hipGetErrorString(e), grid);
}
```

```cpp
#include <hip/hip_runtime.h>
#include <hip/hip_cooperative_groups.h>
#include <cstdint>
#include <cstdio>
namespace cg = cooperative_groups;

#define LAS __attribute__((address_space(3)))
typedef unsigned short bf16_t;
typedef short bf16x8 __attribute__((ext_vector_type(8)));
typedef float f32x4 __attribute__((ext_vector_type(4)));
typedef float f32x16 __attribute__((ext_vector_type(16)));
typedef unsigned u32x4 __attribute__((ext_vector_type(4)));
typedef unsigned u32x2 __attribute__((ext_vector_type(2)));

constexpr int MP = 65536, MS = 1024, MT = MP + MS;
constexpr int DM = 1024, NIN = 5376, DFF = 2816, NGU = 2 * DFF;
constexpr int SKEYS = 1088;
constexpr float EPS = 1e-6f;

constexpr size_t O_Y = 0, O_AKP = 68157440, O_AVP = 76546048, O_IKP = 84934656, O_PLP = 87031808, O_MKP = 87093248, O_MVP = 88141824,
                 O_AKS = 89190400, O_AVS = 89321472, O_IKS = 89452544, O_PLS = 89485312;

constexpr size_t MiB = 1u << 20;
constexpr size_t WS_CTL = 0;
constexpr size_t WS_WIN = 1 * MiB;
constexpr size_t WS_WMEM = 12 * MiB;
constexpr size_t WS_WPOOL = 14 * MiB;
constexpr size_t WS_WOA = 15 * MiB, WS_WOB = 16 * MiB, WS_WOM = 17 * MiB;
constexpr size_t WS_WOUT = 18 * MiB;
constexpr size_t WS_WGU = 20 * MiB;
constexpr size_t WS_WDN = 31 * MiB;
constexpr size_t WS_MEMN = 37 * MiB;
constexpr size_t WS_KVMEM = 41 * MiB;
constexpr size_t WS_MKB = 45 * MiB;
constexpr size_t WS_MVT = 51 * MiB;
constexpr size_t WS_KVS = 57 * MiB;
constexpr size_t WS_KIS = 66 * MiB;
constexpr size_t WS_KI = 68 * MiB;
constexpr size_t WS_WI = 73 * MiB;
constexpr size_t WS_KW32 = 76 * MiB;
constexpr size_t WS_H = 93 * MiB;
constexpr size_t WS_QA = 223 * MiB;
constexpr size_t WS_KV = 288 * MiB;
constexpr size_t WS_QI = 321 * MiB;
constexpr size_t WS_UB = 354 * MiB;
constexpr size_t WS_QM = 419 * MiB;
constexpr size_t WS_PP = 484 * MiB;
constexpr size_t WS_G = 549 * MiB;
constexpr size_t WS_KV8 = 940 * MiB;
constexpr size_t WS_QA8 = 958 * MiB;
constexpr size_t WS_KVS8 = 991 * MiB;
constexpr size_t WS_QL = 996 * MiB;
constexpr size_t WS_WDN2 = 1001 * MiB;
constexpr size_t WS_END = 1007 * MiB;

constexpr int LDS_BYTES = 163840;

namespace pg8 {
constexpr int BM = 256, BK = 64, HALF = 128, HTB = HALF * BK * 2, NXCD = 8, WGM = 4;
__device__ __forceinline__ void stage_rc(int b, int& R, int& C) { const int st = b / 1024, sb = b % 1024, swz = sb ^ (((sb >> 9) & 1) << 5); R = (st >> 1) * 16 + swz / 64; C = (st & 1) * 32 + (swz % 64) / 2; }
__device__ __forceinline__ int lds_byte(int r, int c) { const int st = (r >> 4) * 2 + (c >> 5), rr = r & 15, cc = c & 31, ob = rr * 64 + cc * 2; return st * 1024 + (ob ^ (((ob >> 9) & 1) << 5)); }
__device__ __forceinline__ int perm32(int rho) { const int n = rho >> 4, i = rho & 15; return 8 * (i >> 2) + 4 * n + (i & 3); }
struct Unit { int pm, pn, sub; };
struct Gemm { const bf16_t* A; const bf16_t* Bt; int M, N, K, lda, ldb, a_pn_off; const bf16_t *A1, *A2, *B1, *B2; int a_pn_shift; };
struct StaticOrder {
    int nM, nN, nwg, G, c;
    __device__ void init(int M, int N, int G_, int c_) { nM = M / BM; nN = N / BM; nwg = nM * nN; G = G_; c = c_; }
    __device__ bool next(int i, Unit& u) const {
        const long L = (long)i * G + c; if (L >= nwg) return false;
        int wgid = (int)L; { const int q = nwg / NXCD, r = nwg % NXCD, xcd = wgid % NXCD, off = wgid / NXCD; wgid = (xcd < r ? xcd * (q + 1) : r * (q + 1) + (xcd - r) * q) + off; }
        const int nig = WGM * nN, gid = wgid / nig, fm = gid * WGM, gsz = (nM - fm) < WGM ? (nM - fm) : WGM;
        u.pm = fm + ((wgid % nig) % gsz); u.pn = (wgid % nig) / gsz; u.sub = 0; return true;
    }
};
struct ChainOrder3 {
    StaticOrder base;
    __device__ bool next(int i, Unit& u) const { if (!base.next(i / 3, u)) return false; u.sub = i % 3; return true; }
};
__device__ __forceinline__ unsigned cvt_pk_bf16(float lo, float hi) { unsigned r; asm volatile("v_cvt_pk_bf16_f32 %0, %1, %2" : "=v"(r) : "v"(lo), "v"(hi)); return r; }

template <class Epi, class Sched>
__device__ __forceinline__ void gemm_phase(LAS unsigned char* lds, const Gemm g, const Sched& S, const Epi& E) {
    const int tid = threadIdx.x, wid = __builtin_amdgcn_readfirstlane(tid >> 6), lane = tid & 63, wr = wid >> 2, wc = wid & 3, fr = lane & 15, fq = lane >> 4;
    const int K = g.K, nt = K / BK;
    unsigned voffA[2], voffB[2];
#pragma unroll
    for (int i = 0; i < 2; ++i) { int R, C; stage_rc(tid * 16 + i * 8192, R, C); const int Rb = (R & ~31) + perm32(R & 31);
        voffA[i] = (unsigned)(R * g.lda + C) * 2u; voffB[i] = (unsigned)(Rb * g.ldb + C) * 2u; }
    const size_t kstep = (size_t)(BK * 2);
    const size_t hstepA = (size_t)HALF * g.lda * 2, hstepB = (size_t)HALF * g.ldb * 2;
    const size_t tstepA = 2 * hstepA, tstepB = 2 * hstepB;
    const unsigned ldsw = (unsigned)wid * 1024u;
    const int aoff = lds_byte(wr * 64 + fr, fq * 8), boff = lds_byte(wc * 32 + fr, fq * 8);
#define PG8_SA(b, h) (((b) * 2 + (h)) * HTB)
#define PG8_SB(b, h) ((4 + (b) * 2 + (h)) * HTB)
#define PG8_STAGE(bufoff, gbase, voff) do { _Pragma("unroll") for (int _i = 0; _i < 2; ++_i) \
        __builtin_amdgcn_global_load_lds((const unsigned*)((const char*)(gbase) + (voff)[_i]), (LAS unsigned*)(lds + (bufoff) + ldsw + _i * 8192), 16, 0, 0); } while (0)
#define PG8_LDA(dst, b, h) do { _Pragma("unroll") for (int m = 0; m < 4; ++m) _Pragma("unroll") for (int k = 0; k < 2; ++k) dst[m][k] = *(const LAS bf16x8*)(lds + PG8_SA(b, h) + aoff + m * 2048 + k * 1024); } while (0)
#define PG8_LDB(dst, b, h) do { _Pragma("unroll") for (int n = 0; n < 2; ++n) _Pragma("unroll") for (int k = 0; k < 2; ++k) dst[n][k] = *(const LAS bf16x8*)(lds + PG8_SB(b, h) + boff + n * 2048 + k * 1024); } while (0)
#define PG8_MMA(ai, bj, At, Bt) do { __builtin_amdgcn_s_setprio(1); _Pragma("unroll") for (int m = 0; m < 4; ++m) _Pragma("unroll") for (int n = 0; n < 2; ++n) _Pragma("unroll") for (int k = 0; k < 2; ++k) \
        acc[ai][bj][m][n] = __builtin_amdgcn_mfma_f32_16x16x32_bf16(Bt[n][k], At[m][k], acc[ai][bj][m][n], 0, 0, 0); __builtin_amdgcn_s_setprio(0); } while (0)
#define PG8_WAIT_V(n) asm volatile("s_waitcnt vmcnt(" #n ")" ::: "memory")
#define PG8_WAIT_L(n) asm volatile("s_waitcnt lgkmcnt(" #n ")" ::: "memory")
#define PG8_BAR __builtin_amdgcn_s_barrier()
#define PG8_SCHED __builtin_amdgcn_sched_barrier(0)
    Unit cur, nxt; int ui = 0;
    if (!S.next(0, cur)) return;
    f32x4 acc[2][2][4][2];
#pragma unroll
    for (int a = 0; a < 2; ++a)
#pragma unroll
        for (int b = 0; b < 2; ++b)
#pragma unroll
            for (int m = 0; m < 4; ++m)
#pragma unroll
                for (int n = 0; n < 2; ++n) acc[a][b][m][n] = (f32x4){0.f, 0.f, 0.f, 0.f};
    bf16x8 At[4][2], B0[2][2], B1[2][2];
#define PG8_ABASE(u_) ((const char*)((u_).sub == 0 ? g.A : ((u_).sub == 1 ? g.A1 : g.A2)) + (size_t)(u_).pm * tstepA + (size_t)((u_).pn >> g.a_pn_shift) * g.a_pn_off * 2)
#define PG8_BBASE(u_) ((const char*)((u_).sub == 0 ? g.Bt : ((u_).sub == 1 ? g.B1 : g.B2)) + (size_t)(u_).pn * tstepB)
    const char* cA = PG8_ABASE(cur); const char* cB = PG8_BBASE(cur);
    PG8_STAGE(PG8_SB(0, 0), cB, voffB); PG8_STAGE(PG8_SB(0, 1), cB + hstepB, voffB); PG8_STAGE(PG8_SA(0, 0), cA, voffA); PG8_STAGE(PG8_SA(0, 1), cA + hstepA, voffA);
    if (wr == 1) PG8_BAR;
    PG8_WAIT_V(2); PG8_BAR;
    PG8_STAGE(PG8_SB(1, 0), cB + kstep, voffB); PG8_STAGE(PG8_SA(1, 0), cA + kstep, voffA); PG8_STAGE(PG8_SB(1, 1), cB + hstepB + kstep, voffB);
    PG8_WAIT_V(6); PG8_BAR;
    for (;;) {
        const bool has_next = S.next(ui + 1, nxt);
        const char* nA = has_next ? PG8_ABASE(nxt) : cA; const char* nB = has_next ? PG8_BBASE(nxt) : cB;
        for (int t = 0; t < nt; t += 2) {
            const bool last = (t == nt - 2);
            const char* a1 = cA + (size_t)(t + 1) * kstep;
            const char* a2 = last ? nA : cA + (size_t)(t + 2) * kstep; const char* b2 = last ? nB : cB + (size_t)(t + 2) * kstep;
            const char* a3 = a2 + kstep; const char* b3 = b2 + kstep;
            PG8_LDB(B0, 0, 0); PG8_LDB(B1, 0, 1); PG8_SCHED; PG8_LDA(At, 0, 0); PG8_STAGE(PG8_SA(1, 1), a1 + hstepA, voffA);
            PG8_WAIT_V(8); PG8_WAIT_L(0); PG8_BAR; PG8_MMA(0, 0, At, B0); PG8_MMA(0, 1, At, B1); PG8_BAR; PG8_SCHED;
            PG8_LDA(At, 0, 1); PG8_STAGE(PG8_SB(0, 0), b2, voffB); PG8_STAGE(PG8_SB(0, 1), b2 + hstepB, voffB); PG8_STAGE(PG8_SA(0, 0), a2, voffA);
            PG8_WAIT_V(8); PG8_WAIT_L(0); PG8_BAR; PG8_MMA(1, 0, At, B0); PG8_MMA(1, 1, At, B1); PG8_BAR; PG8_SCHED;
            PG8_LDB(B0, 1, 0); PG8_LDB(B1, 1, 1); PG8_SCHED; PG8_LDA(At, 1, 0); PG8_STAGE(PG8_SA(0, 1), a2 + hstepA, voffA);
            PG8_WAIT_V(8); PG8_WAIT_L(0); PG8_BAR; PG8_MMA(0, 0, At, B0); PG8_MMA(0, 1, At, B1); PG8_BAR; PG8_SCHED;
            PG8_LDA(At, 1, 1); PG8_STAGE(PG8_SB(1, 0), b3, voffB); PG8_STAGE(PG8_SB(1, 1), b3 + hstepB, voffB); PG8_STAGE(PG8_SA(1, 0), a3, voffA);
            PG8_WAIT_V(8); PG8_WAIT_L(0); PG8_BAR; PG8_MMA(1, 0, At, B0); PG8_MMA(1, 1, At, B1); PG8_BAR; PG8_SCHED;
        }
        if (wr == 0) PG8_BAR;
        E(acc, cur, wr, wc, fr, fq);
        if (!has_next) break;
        if (!Epi::CHAIN || cur.sub == 2) {
#pragma unroll
        for (int a = 0; a < 2; ++a)
#pragma unroll
            for (int b = 0; b < 2; ++b)
#pragma unroll
                for (int m = 0; m < 4; ++m)
#pragma unroll
                    for (int n = 0; n < 2; ++n) acc[a][b][m][n] = (f32x4){0.f, 0.f, 0.f, 0.f};
        }
        cur = nxt; cA = nA; cB = nB; ++ui;
        if (wr == 1) PG8_BAR;
    }
    PG8_WAIT_V(0);
    PG8_BAR;
#undef PG8_ABASE
#undef PG8_BBASE
#undef PG8_SA
#undef PG8_SB
#undef PG8_STAGE
#undef PG8_LDA
#undef PG8_LDB
#undef PG8_MMA
#undef PG8_WAIT_V
#undef PG8_WAIT_L
#undef PG8_BAR
#undef PG8_SCHED
}
}
using pg8::cvt_pk_bf16;

enum { EP_INPROJ = 0, EP_BF16, EP_MERGE0, EP_MERGE1, EP_MERGE2, EP_WOUT, EP_UP, EP_DOWN, EP_CHAIN, EP_DOWN_PART };
struct EpiArgs {
    bf16_t *QA, *KV, *QI, *UB, *QM, *G; float* KW32;
    bf16_t* O; int ldc; const float* cs;
    float* Y; const float* xp; const float* xs;
    bf16_t* HID;
    bf16_t* XG; float* SS; const float* gf;
};
__device__ __forceinline__ float sigmoidf_(float x) { return __builtin_amdgcn_rcpf(1.0f + __expf(-x)); }
__device__ __forceinline__ float bflo(unsigned u) { return __uint_as_float(u << 16); }
__device__ __forceinline__ float bfhi(unsigned u) { return __uint_as_float(u & 0xffff0000u); }

__device__ __forceinline__ void unpack8(const u32x4 q, float (&v)[8]);
template <int MODE> struct Epi {
    static constexpr bool CHAIN = (MODE == EP_CHAIN);
    EpiArgs p;
    __device__ __forceinline__ void operator()(f32x4 (&acc)[2][2][4][2], const pg8::Unit& u, int wr, int wc, int fr, int fq) const {
        const int row0 = u.pm * 256 + wr * 64 + fr, cw = wc * 32 + 8 * fq, pn = u.pn;
        if constexpr (MODE == EP_INPROJ) {
            if (pn == 4) {
                if (cw < 64) {
#pragma unroll
                    for (int ai = 0; ai < 2; ++ai)
#pragma unroll
                        for (int m = 0; m < 4; ++m) { float* d = p.KW32 + (size_t)(row0 + ai * 128 + m * 16) * 64 + cw;
                            *(f32x4*)d = acc[ai][0][m][0]; *(f32x4*)(d + 4) = acc[ai][0][m][1]; }
                }
                return;
            }
            bf16_t* base; int ld, co; bool sig = false;
            if (pn < 2) { base = p.QA; ld = 512; co = pn * 256; }
            else if (pn == 2) { base = p.KV; ld = 256; co = 0; }
            else if (pn == 3) { base = p.QI; ld = 256; co = 0; }
            else if (pn < 7) { base = p.UB; ld = 512; co = (pn - 5) * 256; }
            else if (pn < 9) { base = p.QM; ld = 512; co = (pn - 7) * 256; }
            else { base = p.G; ld = 3072; co = (pn - 9) * 256; sig = true; }
#pragma unroll
            for (int ai = 0; ai < 2; ++ai)
#pragma unroll
                for (int m = 0; m < 4; ++m) { bf16_t* rp = base + (size_t)(row0 + ai * 128 + m * 16) * ld + co + cw;
#pragma unroll
                    for (int bj = 0; bj < 2; ++bj) { f32x4 v0 = acc[ai][bj][m][0], v1 = acc[ai][bj][m][1];
                        if (sig) {
#pragma unroll
                            for (int e = 0; e < 4; ++e) { v0[e] = sigmoidf_(v0[e]); v1[e] = sigmoidf_(v1[e]); } }
                        u32x4 w; w.x = cvt_pk_bf16(v0[0], v0[1]); w.y = cvt_pk_bf16(v0[2], v0[3]); w.z = cvt_pk_bf16(v1[0], v1[1]); w.w = cvt_pk_bf16(v1[2], v1[3]);
                        *(u32x4*)(rp + bj * 128) = w; } }
        } else if constexpr (MODE == EP_BF16) {
#pragma unroll
            for (int ai = 0; ai < 2; ++ai)
#pragma unroll
                for (int m = 0; m < 4; ++m) { bf16_t* rp = p.O + (size_t)(row0 + ai * 128 + m * 16) * p.ldc + pn * 256 + cw;
#pragma unroll
                    for (int bj = 0; bj < 2; ++bj) { f32x4 v0 = acc[ai][bj][m][0], v1 = acc[ai][bj][m][1];
                        if (p.cs) { const float* c = p.cs + pn * 256 + bj * 128 + cw; v0 = v0 * *(const f32x4*)c; v1 = v1 * *(const f32x4*)(c + 4); }
                        u32x4 w; w.x = cvt_pk_bf16(v0[0], v0[1]); w.y = cvt_pk_bf16(v0[2], v0[3]); w.z = cvt_pk_bf16(v1[0], v1[1]); w.w = cvt_pk_bf16(v1[2], v1[3]);
                        *(u32x4*)(rp + bj * 128) = w; } }
        } else if constexpr (MODE == EP_MERGE0 || MODE == EP_MERGE1 || MODE == EP_MERGE2) {
            constexpr int kb = MODE - EP_MERGE0;
#pragma unroll
            for (int ai = 0; ai < 2; ++ai)
#pragma unroll
                for (int m = 0; m < 4; ++m) { const int row = row0 + ai * 128 + m * 16;
#pragma unroll
                    for (int bj = 0; bj < 2; ++bj) { const int col = pn * 256 + bj * 128 + cw;
                        const u32x4 gq = *(const u32x4*)(p.G + (size_t)row * 3072 + kb * 1024 + col);
                        f32x4 v0 = acc[ai][bj][m][0], v1 = acc[ai][bj][m][1];
                        v0[0] *= bflo(gq.x); v0[1] *= bfhi(gq.x); v0[2] *= bflo(gq.y); v0[3] *= bfhi(gq.y);
                        v1[0] *= bflo(gq.z); v1[1] *= bfhi(gq.z); v1[2] *= bflo(gq.w); v1[3] *= bfhi(gq.w);
                        float* y = p.Y + (size_t)row * 1024 + col;
                        if constexpr (kb == 0) { *(f32x4*)y = v0; *(f32x4*)(y + 4) = v1; }
                        else if constexpr (kb == 1) { *(f32x4*)y = *(const f32x4*)y + v0; *(f32x4*)(y + 4) = *(const f32x4*)(y + 4) + v1; }
                        else { v0 = v0 + *(const f32x4*)y; v1 = v1 + *(const f32x4*)(y + 4);
                            u32x4 w; w.x = cvt_pk_bf16(v0[0], v0[1]); w.y = cvt_pk_bf16(v0[2], v0[3]); w.z = cvt_pk_bf16(v1[0], v1[1]); w.w = cvt_pk_bf16(v1[2], v1[3]);
                            *(u32x4*)(p.G + (size_t)row * 3072 + col) = w; } } }
        } else if constexpr (MODE == EP_CHAIN) {
            const int sub = u.sub;
#pragma unroll
            for (int ai = 0; ai < 2; ++ai)
#pragma unroll
                for (int m = 0; m < 4; ++m) { const int row = row0 + ai * 128 + m * 16;
#pragma unroll
                    for (int bj = 0; bj < 2; ++bj) { const int col = pn * 256 + bj * 128 + cw;
                        bf16_t* gp = p.G + (size_t)row * 3072 + col;
                        float f[8];
                        if (sub == 2) { unpack8(*(const u32x4*)(gp + 2048), f); }
                        else { float nu[8], de[8]; unpack8(*(const u32x4*)(gp + sub * 1024), nu); unpack8(*(const u32x4*)(gp + (sub + 1) * 1024), de);
#pragma unroll
                            for (int e = 0; e < 8; ++e) f[e] = nu[e] * __builtin_amdgcn_rcpf(fmaxf(de[e], 1e-30f)); }
                        f32x4 v0 = acc[ai][bj][m][0], v1 = acc[ai][bj][m][1];
#pragma unroll
                        for (int e = 0; e < 4; ++e) { v0[e] *= f[e]; v1[e] *= f[4 + e]; }
                        acc[ai][bj][m][0] = v0; acc[ai][bj][m][1] = v1;
                        if (sub == 2) { u32x4 w; w.x = cvt_pk_bf16(v0[0], v0[1]); w.y = cvt_pk_bf16(v0[2], v0[3]); w.z = cvt_pk_bf16(v1[0], v1[1]); w.w = cvt_pk_bf16(v1[2], v1[3]);
                            *(u32x4*)gp = w; } } }
        } else if constexpr (MODE == EP_WOUT) {
#pragma unroll
            for (int ai = 0; ai < 2; ++ai)
#pragma unroll
                for (int m = 0; m < 4; ++m) { const int row = row0 + ai * 128 + m * 16;
                    const float* xr = row < MP ? p.xp + (size_t)row * 1024 : p.xs + (size_t)(row - MP) * 1024;
                    float ss = 0.f;
#pragma unroll
                    for (int bj = 0; bj < 2; ++bj) { const int col = pn * 256 + bj * 128 + cw;
                        const f32x4 a0 = *(const f32x4*)(xr + col) + acc[ai][bj][m][0], a1 = *(const f32x4*)(xr + col + 4) + acc[ai][bj][m][1];
                        ss += (a0[0] * a0[0] + a0[1] * a0[1]) + (a0[2] * a0[2] + a0[3] * a0[3]) + (a1[0] * a1[0] + a1[1] * a1[1]) + (a1[2] * a1[2] + a1[3] * a1[3]);
                        u32x4 w; w.x = cvt_pk_bf16(a0[0], a0[1]); w.y = cvt_pk_bf16(a0[2], a0[3]); w.z = cvt_pk_bf16(a1[0], a1[1]); w.w = cvt_pk_bf16(a1[2], a1[3]);
                        *(u32x4*)(p.XG + (size_t)row * 1024 + col) = w; }
                    ss += __shfl_xor(ss, 16); ss += __shfl_xor(ss, 32);
                    if (fq == 0) p.SS[(size_t)row * 16 + pn * 4 + wc] = ss; }
        } else if constexpr (MODE == EP_DOWN) {
#pragma unroll
            for (int ai = 0; ai < 2; ++ai)
#pragma unroll
                for (int m = 0; m < 4; ++m) { const int row = row0 + ai * 128 + m * 16;
#pragma unroll
                    for (int bj = 0; bj < 2; ++bj) { const int col = pn * 256 + bj * 128 + cw; float* y = p.Y + (size_t)row * 1024 + col;
                        float xv[8]; unpack8(*(const u32x4*)(p.XG + (size_t)row * 1024 + col), xv);
                        *(f32x4*)y = (f32x4){xv[0], xv[1], xv[2], xv[3]} + acc[ai][bj][m][0]; *(f32x4*)(y + 4) = (f32x4){xv[4], xv[5], xv[6], xv[7]} + acc[ai][bj][m][1]; } }
        } else if constexpr (MODE == EP_DOWN_PART) {
#pragma unroll
            for (int ai = 0; ai < 2; ++ai)
#pragma unroll
                for (int m = 0; m < 4; ++m) { const int rl = row0 + ai * 128 + m * 16;
#pragma unroll
                    for (int bj = 0; bj < 2; ++bj) { float* y = p.Y + ((size_t)(pn >> 2) * 1024 + rl) * 1024 + (pn & 3) * 256 + bj * 128 + cw;
                        *(f32x4*)y = acc[ai][bj][m][0]; *(f32x4*)(y + 4) = acc[ai][bj][m][1]; } }
        } else if constexpr (MODE == EP_UP) {
#pragma unroll
            for (int ai = 0; ai < 2; ++ai)
#pragma unroll
                for (int m = 0; m < 4; ++m) { const int row = row0 + ai * 128 + m * 16;
                    const f32x4* sp = (const f32x4*)(p.SS + (size_t)row * 16); const f32x4 q0 = sp[0], q1 = sp[1], q2 = sp[2], q3 = sp[3];
                    const float tot = ((q0[0] + q0[1]) + (q0[2] + q0[3])) + ((q1[0] + q1[1]) + (q1[2] + q1[3])) + ((q2[0] + q2[1]) + (q2[2] + q2[3])) + ((q3[0] + q3[1]) + (q3[2] + q3[3]));
                    const float rstd = rsqrtf(tot * (1.f / 1024.f) + EPS);
                    f32x4 v0, v1;
#pragma unroll
                    for (int e = 0; e < 4; ++e) { const float g0 = acc[ai][0][m][0][e] * rstd, g1 = acc[ai][0][m][1][e] * rstd;
                        v0[e] = g0 * sigmoidf_(g0) * (acc[ai][1][m][0][e] * rstd); v1[e] = g1 * sigmoidf_(g1) * (acc[ai][1][m][1][e] * rstd); }
                    u32x4 w; w.x = cvt_pk_bf16(v0[0], v0[1]); w.y = cvt_pk_bf16(v0[2], v0[3]); w.z = cvt_pk_bf16(v1[0], v1[1]); w.w = cvt_pk_bf16(v1[2], v1[3]);
                    *(u32x4*)(p.HID + (size_t)row * DFF + pn * 128 + cw) = w; }
        }
    }
};

__device__ __forceinline__ float wave_sum(float v) {
#pragma unroll
    for (int o = 1; o < 64; o <<= 1) v += __shfl_xor(v, o);
    return v;
}
__device__ __forceinline__ void sincos_red(float a, float& s, float& c) {
    const float k = rintf(a * 0.15915494309189535f);
    float r = fmaf(-k, 6.28125f, a);
    r = fmaf(-k, 1.9353071795864769e-3f, r);
    s = __sinf(r); c = __cosf(r);
}
__device__ __forceinline__ void unpack8(const u32x4 q, float (&v)[8]) {
    v[0] = bflo(q.x); v[1] = bfhi(q.x); v[2] = bflo(q.y); v[3] = bfhi(q.y); v[4] = bflo(q.z); v[5] = bfhi(q.z); v[6] = bflo(q.w); v[7] = bfhi(q.w);
}
__device__ __forceinline__ u32x4 pack8(const float (&v)[8]) {
    u32x4 w; w.x = cvt_pk_bf16(v[0], v[1]); w.y = cvt_pk_bf16(v[2], v[3]); w.z = cvt_pk_bf16(v[4], v[5]); w.w = cvt_pk_bf16(v[6], v[7]); return w;
}
__device__ __forceinline__ void rms_row_1024(const float* xr, const float* g, bf16_t* o, int lane) {
    const f32x4* x4 = (const f32x4*)xr + lane; f32x4 v[4]; float s = 0.f;
#pragma unroll
    for (int j = 0; j < 4; ++j) { v[j] = x4[64 * j]; s += (v[j].x * v[j].x + v[j].y * v[j].y) + (v[j].z * v[j].z + v[j].w * v[j].w); }
    const float rstd = rsqrtf(wave_sum(s) * (1.f / 1024.f) + EPS);
#pragma unroll
    for (int j = 0; j < 4; ++j) { const f32x4 gg = ((const f32x4*)g)[lane + 64 * j];
        u32x2 w; w.x = cvt_pk_bf16(v[j].x * rstd * gg.x, v[j].y * rstd * gg.y); w.y = cvt_pk_bf16(v[j].z * rstd * gg.z, v[j].w * rstd * gg.w);
        *(u32x2*)(o + 4 * lane + 256 * j) = w; }
}
__device__ __forceinline__ void transpose_item(const float* W, int N, int K, bf16_t* WT, int k0, int n0, int col, LAS float* scr, int lane, const float* kscale = nullptr) {
    float tv[32];
#pragma unroll
    for (int i = 0; i < 32; ++i) { const int kk = 2 * i + (lane >> 5); tv[i] = (col >= 0) ? W[(size_t)(k0 + kk) * N + col] : 0.f; }
#pragma unroll
    for (int i = 0; i < 32; ++i) { const int kk = 2 * i + (lane >> 5); scr[kk * 33 + (lane & 31)] = kscale ? tv[i] * kscale[k0 + kk] : tv[i]; }
    asm volatile("s_waitcnt lgkmcnt(0)" ::: "memory");
    const int c = lane & 7;
#pragma unroll
    for (int j = 0; j < 4; ++j) { const int n = (lane >> 3) + 8 * j; const LAS float* s = scr + (8 * c) * 33 + n;
        u32x4 o; o.x = cvt_pk_bf16(s[0 * 33], s[1 * 33]); o.y = cvt_pk_bf16(s[2 * 33], s[3 * 33]); o.z = cvt_pk_bf16(s[4 * 33], s[5 * 33]); o.w = cvt_pk_bf16(s[6 * 33], s[7 * 33]);
        *(u32x4*)(WT + (size_t)(n0 + n) * K + k0 + 8 * c) = o; }
    asm volatile("s_waitcnt lgkmcnt(0)" ::: "memory");
}
__device__ __forceinline__ int map_in(int n) {
    if (n < 1024) return n;
    if (n < 1280) return (n - 1024 < 40) ? n : -1;
    if (n < 1792) return 1064 + (n - 1280);
    if (n < 2304) return 1576 + (n - 1792);
    return 2088 + (n - 2304);
}

struct Args { const float* in[28]; float* out; unsigned char* ws; };

#define MFMA16(a, b, c) __builtin_amdgcn_mfma_f32_16x16x32_bf16((a), (b), (c), 0, 0, 0)
#define MFMA32(a, b, c) __builtin_amdgcn_mfma_f32_32x32x16_bf16((a), (b), (c), 0, 0, 0)
__device__ __forceinline__ bf16x8 pack_p(const f32x4 a, const f32x4 b) {
    u32x4 w; w.x = cvt_pk_bf16(a[0], a[1]); w.y = cvt_pk_bf16(a[2], a[3]); w.z = cvt_pk_bf16(b[0], b[1]); w.w = cvt_pk_bf16(b[2], b[3]);
    return __builtin_bit_cast(bf16x8, w);
}

__device__ __forceinline__ void mem_attn_item(const bf16_t* QM, const bf16_t* Kb  , const bf16_t* VTb  , bf16_t* Mo, int r0, int h, int lane) {
    const int c = lane & 15, q = lane >> 4;
    bf16x8 Bq[4];
#pragma unroll
    for (int ks = 0; ks < 4; ++ks) Bq[ks] = *(const bf16x8*)(QM + (size_t)(r0 + c) * 512 + h * 128 + 32 * ks + 8 * q);
    f32x4 S[16];
#pragma unroll
    for (int kt = 0; kt < 16; ++kt) {
        const bf16_t* kp = Kb + (size_t)(16 * kt + c) * 512 + h * 128 + 8 * q;
        f32x4 s = (f32x4){0.f, 0.f, 0.f, 0.f};
#pragma unroll
        for (int ks = 0; ks < 4; ++ks) s = MFMA16(*(const bf16x8*)(kp + 32 * ks), Bq[ks], s);
        S[kt] = s;
    }
    const float sc = 0.08838834764831845f * 1.4426950408889634f;
    float mx = -3.0e38f;
#pragma unroll
    for (int kt = 0; kt < 16; ++kt)
#pragma unroll
        for (int e = 0; e < 4; ++e) mx = fmaxf(mx, S[kt][e]);
    mx = fmaxf(mx, __shfl_xor(mx, 16)); mx = fmaxf(mx, __shfl_xor(mx, 32));
    float sum = 0.f;
#pragma unroll
    for (int kt = 0; kt < 16; ++kt)
#pragma unroll
        for (int e = 0; e < 4; ++e) { const float pe = __builtin_amdgcn_exp2f((S[kt][e] - mx) * sc); S[kt][e] = pe; sum += pe; }
    sum += __shfl_xor(sum, 16); sum += __shfl_xor(sum, 32);
    const float inv = 1.0f / sum;
    f32x4 O[8];
#pragma unroll
    for (int dt = 0; dt < 8; ++dt) O[dt] = (f32x4){0.f, 0.f, 0.f, 0.f};
#pragma unroll
    for (int u = 0; u < 8; ++u) {
        const bf16x8 Bp = pack_p(S[2 * u] * inv, S[2 * u + 1] * inv);
#pragma unroll
        for (int dt = 0; dt < 8; ++dt) {
            const bf16_t* vp = VTb + (size_t)(16 * dt + c) * 256 + 32 * u + 4 * q;
            const u32x2 lo = *(const u32x2*)vp, hi = *(const u32x2*)(vp + 16);
            u32x4 w; w.x = lo.x; w.y = lo.y; w.z = hi.x; w.w = hi.y;
            O[dt] = MFMA16(__builtin_bit_cast(bf16x8, w), Bp, O[dt]);
        }
    }
#pragma unroll
    for (int dt = 0; dt < 8; ++dt) { u32x2 w; w.x = cvt_pk_bf16(O[dt][0], O[dt][1]); w.y = cvt_pk_bf16(O[dt][2], O[dt][3]);
        *(u32x2*)(Mo + (size_t)(r0 + c) * 512 + h * 128 + 16 * dt + 4 * q) = w; }
}

__device__ __forceinline__ void sparse_attn_query(const bf16_t* QA, const bf16_t* kvb, bf16_t* Ao, int row, const LAS unsigned short* sel, int ntile, int lane) {
    const int c = lane & 15, q = lane >> 4;
#pragma unroll 1
    for (int g = 0; g < 2; ++g) {
        bf16x8 Bq[2];
#pragma unroll
        for (int ks = 0; ks < 2; ++ks) { u32x4 z = (u32x4){0u, 0u, 0u, 0u};
            if (c < 4) z = *(const u32x4*)(QA + (size_t)row * 512 + (4 * g + c) * 64 + 32 * ks + 8 * q);
            Bq[ks] = __builtin_bit_cast(bf16x8, z); }
        const unsigned kofs = (unsigned)(g * 64 + 8 * q) * 2u;
        bf16x8 KA[16][2];
#pragma unroll
        for (int kt = 0; kt < 16; ++kt) { const unsigned ko = (unsigned)sel[16 * kt + c] * 512u + kofs;
            KA[kt][0] = *(const bf16x8*)((const char*)kvb + ko); KA[kt][1] = *(const bf16x8*)((const char*)kvb + ko + 64u); }
        f32x4 S[16];
#pragma unroll
        for (int kt = 0; kt < 16; ++kt) {
            f32x4 s = MFMA16(KA[kt][0], Bq[0], ((f32x4){0.f, 0.f, 0.f, 0.f}));
            s = MFMA16(KA[kt][1], Bq[1], s);
            const bool ok = kt < ntile;
#pragma unroll
            for (int e = 0; e < 4; ++e) s[e] = ok ? s[e] : -__builtin_inff();
            S[kt] = s;
        }
#define VLOAD(XX, u0, nu) do { _Pragma("unroll") for (int u_ = 0; u_ < nu; ++u_) { \
            const u32x2 s0_ = *(const LAS u32x2*)(sel + 32 * (u0 + u_) + 4 * q), s1_ = *(const LAS u32x2*)(sel + 32 * (u0 + u_) + 16 + 4 * q); \
            int sid_[8]; sid_[0] = s0_.x & 0xffff; sid_[1] = s0_.x >> 16; sid_[2] = s0_.y & 0xffff; sid_[3] = s0_.y >> 16; sid_[4] = s1_.x & 0xffff; sid_[5] = s1_.x >> 16; sid_[6] = s1_.y & 0xffff; sid_[7] = s1_.y >> 16; \
            _Pragma("unroll") for (int e_ = 0; e_ < 8; ++e_) XX[u_][e_] = *(const u32x2*)((const char*)kvb + ((unsigned)sid_[e_] * 512u + vofs)); } } while (0)
#define PVSTEP(XX, u0, nu) do { _Pragma("unroll") for (int u_ = 0; u_ < nu; ++u_) { u32x4 w0, w1, w2, w3; \
            w0.x = __builtin_amdgcn_perm(XX[u_][1].x, XX[u_][0].x, 0x05040100u); w0.y = __builtin_amdgcn_perm(XX[u_][3].x, XX[u_][2].x, 0x05040100u); w0.z = __builtin_amdgcn_perm(XX[u_][5].x, XX[u_][4].x, 0x05040100u); w0.w = __builtin_amdgcn_perm(XX[u_][7].x, XX[u_][6].x, 0x05040100u); \
            w1.x = __builtin_amdgcn_perm(XX[u_][1].x, XX[u_][0].x, 0x07060302u); w1.y = __builtin_amdgcn_perm(XX[u_][3].x, XX[u_][2].x, 0x07060302u); w1.z = __builtin_amdgcn_perm(XX[u_][5].x, XX[u_][4].x, 0x07060302u); w1.w = __builtin_amdgcn_perm(XX[u_][7].x, XX[u_][6].x, 0x07060302u); \
            w2.x = __builtin_amdgcn_perm(XX[u_][1].y, XX[u_][0].y, 0x05040100u); w2.y = __builtin_amdgcn_perm(XX[u_][3].y, XX[u_][2].y, 0x05040100u); w2.z = __builtin_amdgcn_perm(XX[u_][5].y, XX[u_][4].y, 0x05040100u); w2.w = __builtin_amdgcn_perm(XX[u_][7].y, XX[u_][6].y, 0x05040100u); \
            w3.x = __builtin_amdgcn_perm(XX[u_][1].y, XX[u_][0].y, 0x07060302u); w3.y = __builtin_amdgcn_perm(XX[u_][3].y, XX[u_][2].y, 0x07060302u); w3.z = __builtin_amdgcn_perm(XX[u_][5].y, XX[u_][4].y, 0x07060302u); w3.w = __builtin_amdgcn_perm(XX[u_][7].y, XX[u_][6].y, 0x07060302u); \
            O[0] = MFMA16(Pk[u0 + u_], __builtin_bit_cast(bf16x8, w0), O[0]); O[1] = MFMA16(Pk[u0 + u_], __builtin_bit_cast(bf16x8, w1), O[1]); \
            O[2] = MFMA16(Pk[u0 + u_], __builtin_bit_cast(bf16x8, w2), O[2]); O[3] = MFMA16(Pk[u0 + u_], __builtin_bit_cast(bf16x8, w3), O[3]); } } while (0)
        const unsigned vofs = (unsigned)(128 + g * 64 + 4 * c) * 2u;
        __builtin_amdgcn_sched_barrier(0);
        u32x2 X0[4][8]; VLOAD(X0, 0, 4);
        __builtin_amdgcn_sched_barrier(0);
        const float sc = 0.125f * 1.4426950408889634f;
        float mx = -3.0e38f;
#pragma unroll
        for (int kt = 0; kt < 16; ++kt)
#pragma unroll
            for (int e = 0; e < 4; ++e) mx = fmaxf(mx, S[kt][e]);
        mx = fmaxf(mx, __shfl_xor(mx, 16)); mx = fmaxf(mx, __shfl_xor(mx, 32));
        float sum = 0.f;
#pragma unroll
        for (int kt = 0; kt < 16; ++kt)
#pragma unroll
            for (int e = 0; e < 4; ++e) { const float pe = __builtin_amdgcn_exp2f((S[kt][e] - mx) * sc); S[kt][e] = pe; sum += pe; }
        sum += __shfl_xor(sum, 16); sum += __shfl_xor(sum, 32);
        const float inv = 1.0f / sum;
        bf16x8 Pk[8];
#pragma unroll
        for (int u = 0; u < 8; ++u) Pk[u] = pack_p(S[2 * u] * inv, S[2 * u + 1] * inv);
        __builtin_amdgcn_sched_barrier(0);
        u32x2 X1[2][8]; VLOAD(X1, 4, 2);
        __builtin_amdgcn_sched_barrier(0);
        f32x4 O[4];
#pragma unroll
        for (int dt = 0; dt < 4; ++dt) O[dt] = (f32x4){0.f, 0.f, 0.f, 0.f};
        PVSTEP(X0, 0, 4);
        __builtin_amdgcn_sched_barrier(0);
        u32x2 X2[2][8]; VLOAD(X2, 6, 2);
        __builtin_amdgcn_sched_barrier(0);
        PVSTEP(X1, 4, 2);
        PVSTEP(X2, 6, 2);
#undef VLOAD
#undef PVSTEP
        if (q == 0) {
#pragma unroll
            for (int hh = 0; hh < 4; ++hh) { u32x2 w; w.x = cvt_pk_bf16(O[0][hh], O[1][hh]); w.y = cvt_pk_bf16(O[2][hh], O[3][hh]);
                *(u32x2*)(Ao + (size_t)row * 512 + (4 * g + hh) * 64 + 4 * c) = w; }
        }
    }
}

__device__ __forceinline__ u32x2 pack8_fp8(const float (&v)[8]) {
    int a = __builtin_amdgcn_cvt_pk_fp8_f32(v[0], v[1], 0, false); a = __builtin_amdgcn_cvt_pk_fp8_f32(v[2], v[3], a, true);
    int b = __builtin_amdgcn_cvt_pk_fp8_f32(v[4], v[5], 0, false); b = __builtin_amdgcn_cvt_pk_fp8_f32(v[6], v[7], b, true);
    u32x2 r; r.x = (unsigned)a; r.y = (unsigned)b; return r;
}
__device__ __forceinline__ long mk64(unsigned lo, unsigned hi) { return (long)(((unsigned long long)hi << 32) | (unsigned long long)lo); }
__device__ __forceinline__ void sparse_attn_query8(const unsigned char* QA8, const unsigned char* kv8, bf16_t* Ao, int row, const LAS unsigned short* sel, int ntile, int lane) {
    const int c = lane & 15, q = lane >> 4;
#pragma unroll 1
    for (int g = 0; g < 2; ++g) {
        long Bq[2];
#pragma unroll
        for (int ks = 0; ks < 2; ++ks) { u32x2 z = (u32x2){0u, 0u};
            if (c < 4) z = *(const u32x2*)(QA8 + (size_t)row * 512 + (4 * g + c) * 64 + 16 * q + 8 * ks);
            Bq[ks] = mk64(z.x, z.y); }
        const unsigned kofs = (unsigned)(g * 64 + 16 * q), vofs = (unsigned)(128 + g * 64 + 4 * c);
        u32x4 KA[16];
#pragma unroll
        for (int kt = 0; kt < 16; ++kt) { const unsigned ko = (unsigned)sel[16 * kt + c] * 256u + kofs;
            KA[kt] = *(const u32x4*)(kv8 + ko); }
        unsigned XV[8][8];
#pragma unroll
        for (int u = 0; u < 8; ++u) {
            const u32x2 s0 = *(const LAS u32x2*)(sel + 32 * u + 4 * q), s1 = *(const LAS u32x2*)(sel + 32 * u + 16 + 4 * q);
            unsigned sid[8]; sid[0] = s0.x & 0xffffu; sid[1] = s0.x >> 16; sid[2] = s0.y & 0xffffu; sid[3] = s0.y >> 16; sid[4] = s1.x & 0xffffu; sid[5] = s1.x >> 16; sid[6] = s1.y & 0xffffu; sid[7] = s1.y >> 16;
#pragma unroll
            for (int e = 0; e < 8; ++e) XV[u][e] = *(const unsigned*)(kv8 + (sid[e] * 256u + vofs));
        }
        f32x4 S[16];
#pragma unroll
        for (int kt = 0; kt < 16; ++kt) {
            f32x4 s = __builtin_amdgcn_mfma_f32_16x16x32_fp8_fp8(mk64(KA[kt].x, KA[kt].y), Bq[0], ((f32x4){0.f, 0.f, 0.f, 0.f}), 0, 0, 0);
            s = __builtin_amdgcn_mfma_f32_16x16x32_fp8_fp8(mk64(KA[kt].z, KA[kt].w), Bq[1], s, 0, 0, 0);
            const bool ok = kt < ntile;
#pragma unroll
            for (int e = 0; e < 4; ++e) s[e] = ok ? s[e] : -__builtin_inff();
            S[kt] = s;
        }
        const float sc = 0.125f * 1.4426950408889634f;
        float mx = -3.0e38f;
#pragma unroll
        for (int kt = 0; kt < 16; ++kt)
#pragma unroll
            for (int e = 0; e < 4; ++e) mx = fmaxf(mx, S[kt][e]);
        mx = fmaxf(mx, __shfl_xor(mx, 16)); mx = fmaxf(mx, __shfl_xor(mx, 32));
        float sum = 0.f;
#pragma unroll
        for (int kt = 0; kt < 16; ++kt)
#pragma unroll
            for (int e = 0; e < 4; ++e) { const float pe = __builtin_amdgcn_exp2f((S[kt][e] - mx) * sc); S[kt][e] = pe; sum += pe; }
        sum += __shfl_xor(sum, 16); sum += __shfl_xor(sum, 32);
        const float inv = 1.0f / sum;
        f32x4 O[4];
#pragma unroll
        for (int dt = 0; dt < 4; ++dt) O[dt] = (f32x4){0.f, 0.f, 0.f, 0.f};
#pragma unroll
        for (int u = 0; u < 8; ++u) {
            int p0 = __builtin_amdgcn_cvt_pk_bf8_f32(S[2 * u][0], S[2 * u][1], 0, false); p0 = __builtin_amdgcn_cvt_pk_bf8_f32(S[2 * u][2], S[2 * u][3], p0, true);
            int p1 = __builtin_amdgcn_cvt_pk_bf8_f32(S[2 * u + 1][0], S[2 * u + 1][1], 0, false); p1 = __builtin_amdgcn_cvt_pk_bf8_f32(S[2 * u + 1][2], S[2 * u + 1][3], p1, true);
            const long Pk = mk64((unsigned)p0, (unsigned)p1);
            const unsigned a0 = __builtin_amdgcn_perm(XV[u][1], XV[u][0], 0x05010400u), b0 = __builtin_amdgcn_perm(XV[u][1], XV[u][0], 0x07030602u);
            const unsigned c0 = __builtin_amdgcn_perm(XV[u][3], XV[u][2], 0x05010400u), d0 = __builtin_amdgcn_perm(XV[u][3], XV[u][2], 0x07030602u);
            const unsigned a1 = __builtin_amdgcn_perm(XV[u][5], XV[u][4], 0x05010400u), b1 = __builtin_amdgcn_perm(XV[u][5], XV[u][4], 0x07030602u);
            const unsigned c1 = __builtin_amdgcn_perm(XV[u][7], XV[u][6], 0x05010400u), d1 = __builtin_amdgcn_perm(XV[u][7], XV[u][6], 0x07030602u);
            const long V0 = mk64(__builtin_amdgcn_perm(c0, a0, 0x05040100u), __builtin_amdgcn_perm(c1, a1, 0x05040100u));
            const long V1 = mk64(__builtin_amdgcn_perm(c0, a0, 0x07060302u), __builtin_amdgcn_perm(c1, a1, 0x07060302u));
            const long V2 = mk64(__builtin_amdgcn_perm(d0, b0, 0x05040100u), __builtin_amdgcn_perm(d1, b1, 0x05040100u));
            const long V3 = mk64(__builtin_amdgcn_perm(d0, b0, 0x07060302u), __builtin_amdgcn_perm(d1, b1, 0x07060302u));
            O[0] = __builtin_amdgcn_mfma_f32_16x16x32_bf8_fp8(Pk, V0, O[0], 0, 0, 0);
            O[1] = __builtin_amdgcn_mfma_f32_16x16x32_bf8_fp8(Pk, V1, O[1], 0, 0, 0);
            O[2] = __builtin_amdgcn_mfma_f32_16x16x32_bf8_fp8(Pk, V2, O[2], 0, 0, 0);
            O[3] = __builtin_amdgcn_mfma_f32_16x16x32_bf8_fp8(Pk, V3, O[3], 0, 0, 0);
        }
        float invh[4];
#pragma unroll
        for (int hh = 0; hh < 4; ++hh) invh[hh] = __shfl(inv, hh);
        if (q == 0) {
#pragma unroll
            for (int hh = 0; hh < 4; ++hh) { u32x2 w; w.x = cvt_pk_bf16(O[0][hh] * invh[hh], O[1][hh] * invh[hh]); w.y = cvt_pk_bf16(O[2][hh] * invh[hh], O[3][hh] * invh[hh]);
                *(u32x2*)(Ao + (size_t)row * 512 + (4 * g + hh) * 64 + 4 * c) = w; }
        }
    }
}

template <int NQ>
__device__ __forceinline__ void sparse_attn_lds(const unsigned char* QA8, const unsigned char* kv8, bf16_t* Ao, int qrow0, const LAS unsigned short* selb, LAS unsigned char* buf, int nch, int lane) {
    const int c = lane & 15, q = lane >> 4;
    long Bq[NQ][2][2];
#pragma unroll
    for (int qq = 0; qq < NQ; ++qq)
#pragma unroll
        for (int g = 0; g < 2; ++g)
#pragma unroll
            for (int ks = 0; ks < 2; ++ks) { u32x2 z = (u32x2){0u, 0u};
                if (c < 4) z = *(const u32x2*)(QA8 + (size_t)(qrow0 + qq) * 512 + (4 * g + c) * 64 + 16 * q + 8 * ks);
                Bq[qq][g][ks] = mk64(z.x, z.y); }
    const int nsteps = NQ * nch;
    asm volatile("s_waitcnt lgkmcnt(0)" ::: "memory");
#define DMA_CHUNK(qq_, u_) do { const LAS unsigned short* sp_ = selb + (qq_) * 256 + (u_) * 32; LAS unsigned char* db_ = buf + ((u_) & 1) * 8192; \
        _Pragma("unroll") for (int p = 0; p < 8; ++p) { const int r_ = 4 * p + q; const unsigned src_ = (unsigned)sp_[r_] * 256u + 16u * (unsigned)(c ^ (r_ & 15)); \
            __builtin_amdgcn_global_load_lds((const unsigned*)(kv8 + src_), (LAS unsigned*)(db_ + p * 1024), 16, 0, 0); } } while (0)
    DMA_CHUNK(0, 0);
    DMA_CHUNK(0, 1);
    const float sc = 0.125f * 1.4426950408889634f;
    int sidx = 0;
#pragma unroll
    for (int qq = 0; qq < NQ; ++qq) {
        float m0 = -3.0e38f, m1 = -3.0e38f, l0 = 0.f, l1 = 0.f;
        f32x4 O[2][4];
#pragma unroll
        for (int g = 0; g < 2; ++g)
#pragma unroll
            for (int dt = 0; dt < 4; ++dt) O[g][dt] = (f32x4){0.f, 0.f, 0.f, 0.f};
#pragma unroll 1
        for (int u = 0; u < nch; ++u, ++sidx) {
            if (sidx + 1 < nsteps) asm volatile("s_waitcnt vmcnt(8)" ::: "memory"); else asm volatile("s_waitcnt vmcnt(0)" ::: "memory");
            const LAS unsigned char* b_ = buf + (u & 1) * 8192;
#pragma unroll
            for (int g = 0; g < 2; ++g) {
                const unsigned kslot = (unsigned)(((4 * g + q) ^ c) * 16);
                const u32x4 ka0 = *(const LAS u32x4*)(b_ + c * 256 + kslot), ka1 = *(const LAS u32x4*)(b_ + (16 + c) * 256 + kslot);
                f32x4 s0 = __builtin_amdgcn_mfma_f32_16x16x32_fp8_fp8(mk64(ka0.x, ka0.y), Bq[qq][g][0], ((f32x4){0.f, 0.f, 0.f, 0.f}), 0, 0, 0);
                s0 = __builtin_amdgcn_mfma_f32_16x16x32_fp8_fp8(mk64(ka0.z, ka0.w), Bq[qq][g][1], s0, 0, 0, 0);
                f32x4 s1 = __builtin_amdgcn_mfma_f32_16x16x32_fp8_fp8(mk64(ka1.x, ka1.y), Bq[qq][g][0], ((f32x4){0.f, 0.f, 0.f, 0.f}), 0, 0, 0);
                s1 = __builtin_amdgcn_mfma_f32_16x16x32_fp8_fp8(mk64(ka1.z, ka1.w), Bq[qq][g][1], s1, 0, 0, 0);
                float cm = fmaxf(fmaxf(fmaxf(s0[0], s0[1]), fmaxf(s0[2], s0[3])), fmaxf(fmaxf(s1[0], s1[1]), fmaxf(s1[2], s1[3])));
                cm = fmaxf(cm, __shfl_xor(cm, 16)); cm = fmaxf(cm, __shfl_xor(cm, 32));
                const float mo = g ? m1 : m0, mn = fmaxf(mo, cm);
                const float al = __builtin_amdgcn_exp2f((mo - mn) * sc);
                float ls = 0.f;
#pragma unroll
                for (int e = 0; e < 4; ++e) { s0[e] = __builtin_amdgcn_exp2f((s0[e] - mn) * sc); s1[e] = __builtin_amdgcn_exp2f((s1[e] - mn) * sc); ls += s0[e] + s1[e]; }
                if (g) { m1 = mn; l1 = l1 * al + ls; } else { m0 = mn; l0 = l0 * al + ls; }
                float ah[4];
#pragma unroll
                for (int h = 0; h < 4; ++h) ah[h] = __int_as_float(__builtin_amdgcn_readlane(__float_as_int(al), h));
#pragma unroll
                for (int dt = 0; dt < 4; ++dt)
#pragma unroll
                    for (int h = 0; h < 4; ++h) O[g][dt][h] *= ah[h];
                int p0 = __builtin_amdgcn_cvt_pk_bf8_f32(s0[0], s0[1], 0, false); p0 = __builtin_amdgcn_cvt_pk_bf8_f32(s0[2], s0[3], p0, true);
                int p1 = __builtin_amdgcn_cvt_pk_bf8_f32(s1[0], s1[1], 0, false); p1 = __builtin_amdgcn_cvt_pk_bf8_f32(s1[2], s1[3], p1, true);
                const long Pk = mk64((unsigned)p0, (unsigned)p1);
                unsigned xv[8];
#pragma unroll
                for (int e = 0; e < 8; ++e) { const int r_ = (e < 4) ? 4 * q + e : 16 + 4 * q + (e - 4);
                    xv[e] = *(const LAS unsigned*)(b_ + r_ * 256 + 16 * ((8 + 4 * g + (c >> 2)) ^ (r_ & 15)) + 4 * (c & 3)); }
                const unsigned a0 = __builtin_amdgcn_perm(xv[1], xv[0], 0x05010400u), b0 = __builtin_amdgcn_perm(xv[1], xv[0], 0x07030602u);
                const unsigned c0 = __builtin_amdgcn_perm(xv[3], xv[2], 0x05010400u), d0 = __builtin_amdgcn_perm(xv[3], xv[2], 0x07030602u);
                const unsigned a1 = __builtin_amdgcn_perm(xv[5], xv[4], 0x05010400u), b1 = __builtin_amdgcn_perm(xv[5], xv[4], 0x07030602u);
                const unsigned c1 = __builtin_amdgcn_perm(xv[7], xv[6], 0x05010400u), d1 = __builtin_amdgcn_perm(xv[7], xv[6], 0x07030602u);
                O[g][0] = __builtin_amdgcn_mfma_f32_16x16x32_bf8_fp8(Pk, mk64(__builtin_amdgcn_perm(c0, a0, 0x05040100u), __builtin_amdgcn_perm(c1, a1, 0x05040100u)), O[g][0], 0, 0, 0);
                O[g][1] = __builtin_amdgcn_mfma_f32_16x16x32_bf8_fp8(Pk, mk64(__builtin_amdgcn_perm(c0, a0, 0x07060302u), __builtin_amdgcn_perm(c1, a1, 0x07060302u)), O[g][1], 0, 0, 0);
                O[g][2] = __builtin_amdgcn_mfma_f32_16x16x32_bf8_fp8(Pk, mk64(__builtin_amdgcn_perm(d0, b0, 0x05040100u), __builtin_amdgcn_perm(d1, b1, 0x05040100u)), O[g][2], 0, 0, 0);
                O[g][3] = __builtin_amdgcn_mfma_f32_16x16x32_bf8_fp8(Pk, mk64(__builtin_amdgcn_perm(d0, b0, 0x07060302u), __builtin_amdgcn_perm(d1, b1, 0x07060302u)), O[g][3], 0, 0, 0);
            }
            if (u == nch - 1) {
#pragma unroll
                for (int g = 0; g < 2; ++g) {
                    float lt = g ? l1 : l0; lt += __shfl_xor(lt, 16); lt += __shfl_xor(lt, 32);
                    const float inv = 1.0f / lt;
                    float ih[4];
#pragma unroll
                    for (int h = 0; h < 4; ++h) ih[h] = __int_as_float(__builtin_amdgcn_readlane(__float_as_int(inv), h));
                    if (q == 0) {
#pragma unroll
                        for (int h = 0; h < 4; ++h) { u32x2 w; w.x = cvt_pk_bf16(O[g][0][h] * ih[h], O[g][1][h] * ih[h]); w.y = cvt_pk_bf16(O[g][2][h] * ih[h], O[g][3][h] * ih[h]);
                            *(u32x2*)(Ao + (size_t)(qrow0 + qq) * 512 + (4 * g + h) * 64 + 4 * c) = w; }
                    }
                }
            }
            asm volatile("s_waitcnt lgkmcnt(0)" ::: "memory");
            if (sidx + 2 < nsteps) { int nq_ = qq, nu_ = u + 2; if (nu_ >= nch) { nu_ -= nch; nq_ += 1; } DMA_CHUNK(nq_, nu_); }
        }
    }
#undef DMA_CHUNK
}

__device__ __forceinline__ void scan_hist(const LAS unsigned* hq, int need, int lane, int& bin, int& above) {
    int sum = 0;
#pragma unroll
    for (int w = 0; w < 16; ++w) { const unsigned x = hq[16 * lane + w]; sum += (int)(x & 0xffffu) + (int)(x >> 16); }
    int suf = sum;
#pragma unroll
    for (int off = 1; off < 64; off <<= 1) { const int v = __shfl_down(suf, off); if (lane + off < 64) suf += v; }
    int nx = __shfl_down(suf, 1); if (lane == 63) nx = 0;
    const bool hit = (suf >= need) && (nx < need);
    const unsigned long long mk = __ballot(hit);
    const int L = mk ? (int)__builtin_ctzll(mk) : 0;
    const int aboveL = __shfl(nx, L);
    const unsigned xw = hq[16 * L + ((lane & 31) >> 1)];
    int cj = (lane & 1) ? (int)(xw >> 16) : (int)(xw & 0xffffu); if (lane >= 32) cj = 0;
    int suf2 = cj;
#pragma unroll
    for (int off = 1; off < 32; off <<= 1) { const int v = __shfl_down(suf2, off); if (lane + off < 64) suf2 += v; }
    int nx2 = __shfl_down(suf2, 1); if (lane == 63) nx2 = 0;
    const int need2 = need - aboveL;
    const bool hit2 = (lane < 32) && (suf2 >= need2) && (nx2 < need2);
    const unsigned long long mk2 = __ballot(hit2);
    const int J = mk2 ? (int)__builtin_ctzll(mk2) : 0;
    bin = 32 * L + J; above = aboveL + __shfl(nx2, J);
}

__device__ __forceinline__ void scan_hist1024(const LAS unsigned* hq, int need, int lane, int& bin, int& above, int& inbin) {
    int sum = 0;
#pragma unroll
    for (int w = 0; w < 8; ++w) { const unsigned x = hq[8 * lane + w]; sum += (int)(x & 0xffffu) + (int)(x >> 16); }
    int suf = sum;
#pragma unroll
    for (int off = 1; off < 64; off <<= 1) { const int v = __shfl_down(suf, off); if (lane + off < 64) suf += v; }
    int nx = __shfl_down(suf, 1); if (lane == 63) nx = 0;
    const bool hit = (suf >= need) && (nx < need);
    const unsigned long long mk = __ballot(hit);
    const int L = mk ? (int)__builtin_ctzll(mk) : 0;
    const int aboveL = __shfl(nx, L);
    const unsigned xw = hq[8 * L + ((lane & 15) >> 1)];
    int cj = (lane & 1) ? (int)(xw >> 16) : (int)(xw & 0xffffu); if (lane >= 16) cj = 0;
    int suf2 = cj;
#pragma unroll
    for (int off = 1; off < 16; off <<= 1) { const int v = __shfl_down(suf2, off); if (lane + off < 64) suf2 += v; }
    int nx2 = __shfl_down(suf2, 1); if (lane == 63) nx2 = 0;
    const int need2 = need - aboveL;
    const bool hit2 = (lane < 16) && (suf2 >= need2) && (nx2 < need2);
    const unsigned long long mk2 = __ballot(hit2);
    const int J = mk2 ? (int)__builtin_ctzll(mk2) : 0;
    bin = 16 * L + J; above = aboveL + __shfl(nx2, J); inbin = __shfl(cj, J);
}

__device__ __forceinline__ void radix_select4(const bf16_t* QI, const float* WI, const bf16_t* kib, int n, int qrow0, LAS unsigned* hist, LAS unsigned short* selb, int lane) {
    const int hf = lane >> 5, l31 = lane & 31;
    const unsigned lmask = (1u << l31) - 1u;
    bf16x8 A0, A1; float w0[8], w1[8];
    { const int r = l31, qq = 2 * ((r & 7) >> 2) + (r >> 4), hd = 4 * ((r >> 3) & 1) + (r & 3);
      const bf16_t* qp = QI + (size_t)(qrow0 + qq) * 256 + hd * 32 + 8 * hf;
      A0 = *(const bf16x8*)qp; A1 = *(const bf16x8*)(qp + 16);
      const float* wp0 = WI + (size_t)(qrow0 + 2 * hf) * 8;
#pragma unroll
      for (int e = 0; e < 8; ++e) { w0[e] = wp0[e]; w1[e] = wp0[8 + e]; } }
    unsigned pref0 = 0, pref1 = 0;
    int need0 = 256, need1 = 256;
#define SCORE_TILE(s0, k0v, k1v) do { const bf16_t* kp_ = kib + (size_t)((s0) + l31) * 32 + 8 * hf; \
        f32x16 ac_ = {0.f,0.f,0.f,0.f,0.f,0.f,0.f,0.f,0.f,0.f,0.f,0.f,0.f,0.f,0.f,0.f}; \
        ac_ = MFMA32(A0, *(const bf16x8*)kp_, ac_); ac_ = MFMA32(A1, *(const bf16x8*)(kp_ + 16), ac_); \
        float sa_ = 0.f, sb_ = 0.f; \
        _Pragma("unroll") for (int e_ = 0; e_ < 8; ++e_) { sa_ = fmaf(w0[e_], fmaxf(ac_[e_], 0.f), sa_); sb_ = fmaf(w1[e_], fmaxf(ac_[8 + e_], 0.f), sb_); } \
        const unsigned ua_ = __float_as_uint(sa_), ub_ = __float_as_uint(sb_); \
        k0v = (ua_ & 0x80000000u) ? ~ua_ : (ua_ | 0x80000000u); k1v = (ub_ & 0x80000000u) ? ~ub_ : (ub_ | 0x80000000u); } while (0)
#pragma unroll 1
    for (int pass = 0; pass < 3; ++pass) {
        { u32x4 z = (u32x4){0u, 0u, 0u, 0u};
#pragma unroll
          for (int i = 0; i < 16; ++i) *(LAS u32x4*)(hist + 4 * (lane + 64 * i)) = z; }
        const int shp = (pass == 0) ? 21 : (pass == 1 ? 10 : 0);
        const unsigned bmask = (pass == 2) ? 1023u : 2047u;
        const int shm = (pass == 0) ? 31 : (pass == 1 ? 21 : 10);
        for (int s0 = 0; s0 < n; s0 += 32) {
            unsigned k0, k1; SCORE_TILE(s0, k0, k1);
            const bool m0 = (pass == 0) || ((k0 >> shm) == pref0), m1 = (pass == 0) || ((k1 >> shm) == pref1);
            if (m0) { const unsigned bin = (k0 >> shp) & bmask; __hip_atomic_fetch_add(hist + (2 * hf) * 1024 + (bin >> 1), 1u << (16 * (bin & 1)), __ATOMIC_RELAXED, __HIP_MEMORY_SCOPE_WORKGROUP); }
            if (m1) { const unsigned bin = (k1 >> shp) & bmask; __hip_atomic_fetch_add(hist + (2 * hf + 1) * 1024 + (bin >> 1), 1u << (16 * (bin & 1)), __ATOMIC_RELAXED, __HIP_MEMORY_SCOPE_WORKGROUP); }
        }
        int bins[4], abv[4];
#pragma unroll
        for (int qq = 0; qq < 4; ++qq) {
            const int nd = __shfl((qq & 1) ? need1 : need0, (qq >> 1) * 32);
            scan_hist(hist + qq * 1024, nd, lane, bins[qq], abv[qq]);
        }
        const int b0 = hf ? bins[2] : bins[0], b1 = hf ? bins[3] : bins[1], a0 = hf ? abv[2] : abv[0], a1 = hf ? abv[3] : abv[1];
        if (pass == 0) { pref0 = (unsigned)b0; pref1 = (unsigned)b1; }
        else if (pass == 1) { pref0 = (pref0 << 11) | (unsigned)b0; pref1 = (pref1 << 11) | (unsigned)b1; }
        else { pref0 = (pref0 << 10) | (unsigned)b0; pref1 = (pref1 << 10) | (unsigned)b1; }
        need0 -= a0; need1 -= a1;
    }
    int cnt0 = 0, cnt1 = 0, tie0 = 0, tie1 = 0;
    for (int s0 = 0; s0 < n; s0 += 32) {
        unsigned k0, k1; SCORE_TILE(s0, k0, k1);
        {
            const bool eq = (k0 == pref0); const unsigned long long bt = __ballot(eq); const unsigned hb = hf ? (unsigned)(bt >> 32) : (unsigned)bt;
            const bool take = (k0 > pref0) || (eq && (tie0 + (int)__popc(hb & lmask) < need0)); tie0 += (int)__popc(hb);
            const unsigned long long bs = __ballot(take); const unsigned hs = hf ? (unsigned)(bs >> 32) : (unsigned)bs;
            const int pos = cnt0 + (int)__popc(hs & lmask); cnt0 += (int)__popc(hs);
            if (take && pos < 256) selb[(2 * hf) * 256 + pos] = (unsigned short)(s0 + l31);
        }
        {
            const bool eq = (k1 == pref1); const unsigned long long bt = __ballot(eq); const unsigned hb = hf ? (unsigned)(bt >> 32) : (unsigned)bt;
            const bool take = (k1 > pref1) || (eq && (tie1 + (int)__popc(hb & lmask) < need1)); tie1 += (int)__popc(hb);
            const unsigned long long bs = __ballot(take); const unsigned hs = hf ? (unsigned)(bs >> 32) : (unsigned)bs;
            const int pos = cnt1 + (int)__popc(hs & lmask); cnt1 += (int)__popc(hs);
            if (take && pos < 256) selb[(2 * hf + 1) * 256 + pos] = (unsigned short)(s0 + l31);
        }
    }
#undef SCORE_TILE
}

#define XB_TMO      128
#define XB_XCNT(j)  (256  + 64 * (j))
#define XB_XSUB(j)  (1280 + 64 * (j))
#define XB_XGEN(j)  (2304 + 64 * (j))
#define XB_TOP      3328
#define XB_TOPGEN   3392
#define XCD_BAR_WORDS 3456
#define XB_SPIN_CAP (1u << 18)

__device__ __forceinline__ unsigned xb_ld(unsigned* p)              { return __hip_atomic_load(p, __ATOMIC_RELAXED, __HIP_MEMORY_SCOPE_AGENT); }
__device__ __forceinline__ unsigned xb_add(unsigned* p, unsigned v) { return __hip_atomic_fetch_add(p, v, __ATOMIC_RELAXED, __HIP_MEMORY_SCOPE_AGENT); }
__device__ __forceinline__ unsigned xb_xcc_id() { return (unsigned)__builtin_amdgcn_s_getreg((3 << 11) | 20) & 0xFu; }
#define XB_SPIN(cond, bar) do { unsigned _sp = 0; while (cond) { __builtin_amdgcn_s_sleep(1); \
    if ((++_sp & 255u) == 0u) { if (xb_ld(&(bar)[XB_TMO])) break; if (_sp > XB_SPIN_CAP) { atomicAdd(&(bar)[XB_TMO], 1u); break; } } } } while (0)

struct XcdBarrier {
    unsigned* bar; unsigned x;
    volatile unsigned* st;
};

__device__ __forceinline__ XcdBarrier xcd_barrier_post(unsigned* bar, volatile unsigned* st) {
    XcdBarrier b; b.bar = bar; b.x = xb_xcc_id(); b.st = st;
    if (threadIdx.x == 0) (void)xb_add(&bar[XB_XCNT(b.x)], 1u);
    return b;
}
__device__ __forceinline__ void xcd_barrier_complete(unsigned* bar, unsigned x, unsigned& nloc, unsigned& nx) {
    const unsigned G = gridDim.x * gridDim.y * gridDim.z;
    unsigned sum, cnt, mine, sp = 0u;
    for (;;) {
        sum = 0u; cnt = 0u; mine = 0u;
#pragma unroll
        for (unsigned j = 0; j < 16; ++j) { const unsigned c = xb_ld(&bar[XB_XCNT(j)]); sum += c; cnt += (c > 0u) ? 1u : 0u; mine = (j == x) ? c : mine; }
        if (sum == G) break;
        __builtin_amdgcn_s_sleep(1);
        if ((++sp & 255u) == 0u) { if (xb_ld(&bar[XB_TMO])) break; if (sp > XB_SPIN_CAP) { atomicAdd(&bar[XB_TMO], 1u); break; } }
    }
    nloc = mine > 0u ? mine : 1u; nx = cnt > 0u ? cnt : 1u;
}

__device__ __forceinline__ void xcd_barrier(const XcdBarrier& b) {
    asm volatile("s_waitcnt vmcnt(0)" ::: "memory");
    __syncthreads();
    if (threadIdx.x == 0) {
        unsigned* bar = b.bar;
        __builtin_amdgcn_s_waitcnt(0);
        unsigned nloc = b.st[0], nx = b.st[1];
        if (nloc == 0u) { xcd_barrier_complete(bar, b.x, nloc, nx); b.st[0] = nloc; b.st[1] = nx; }
        const unsigned old = xb_add(&bar[XB_XSUB(b.x)], 1u);
        const unsigned gen = old / nloc;
        if (old + 1u == (gen + 1u) * nloc) {
            __builtin_amdgcn_fence(__ATOMIC_RELEASE, "agent");
            asm volatile("s_waitcnt vmcnt(0)" ::: "memory");
            const unsigned og = xb_add(&bar[XB_TOP], 1u);
            const unsigned tg = og / nx;
            if (og + 1u == (tg + 1u) * nx) xb_add(&bar[XB_TOPGEN], 1u);
            else XB_SPIN(xb_ld(&bar[XB_TOPGEN]) == tg, bar);
            __builtin_amdgcn_fence(__ATOMIC_ACQUIRE, "agent");
            xb_add(&bar[XB_XGEN(b.x)], 1u);
            asm volatile("s_waitcnt vmcnt(0)" ::: "memory");
        } else {
            XB_SPIN(xb_ld(&bar[XB_XGEN(b.x)]) == gen, bar);
            __builtin_amdgcn_fence(__ATOMIC_ACQUIRE, "agent");
            asm volatile("s_waitcnt vmcnt(0)" ::: "memory");
        }
    }
    __syncthreads();
}

__global__ void __launch_bounds__(512, 2) fwd_kernel(Args a) {
    extern __shared__ __attribute__((aligned(16))) unsigned char lds_raw[];
    LAS unsigned char* lds = (LAS unsigned char*)lds_raw;
    cg::grid_group grid = cg::this_grid();
    const int tid = threadIdx.x, lane = tid & 63, wave = __builtin_amdgcn_readfirstlane(tid >> 6);
    const int G = gridDim.x, gw = blockIdx.x * 8 + wave, NGW = G * 8;
    unsigned char* ws = a.ws; float* out = a.out;
    const float *x_prompt = a.in[0], *x_sample = a.in[1], *mem_prompt = a.in[2], *cache_a_k = a.in[3], *cache_a_v = a.in[4], *cache_idx_k = a.in[5], *cache_pool = a.in[6],
                *cache_mem_k = a.in[7], *cache_mem_v = a.in[8], *g_mix = a.in[9], *w_in = a.in[10], *g_qa = a.in[11], *g_ka = a.in[12], *g_kidx = a.in[13], *g_qm = a.in[14],
                *g_mem = a.in[15], *w_mem_kv = a.in[16], *g_km = a.in[17], *w_pool = a.in[18], *s_pool = a.in[19], *w_oa = a.in[20], *w_ob = a.in[21], *w_om = a.in[22],
                *w_out = a.in[23], *g_ffn = a.in[24], *w_gate = a.in[25], *w_up = a.in[26], *w_down = a.in[27];
    bf16_t *WIN = (bf16_t*)(ws + WS_WIN), *WMEM = (bf16_t*)(ws + WS_WMEM), *WPOOL = (bf16_t*)(ws + WS_WPOOL), *WOA = (bf16_t*)(ws + WS_WOA), *WOB = (bf16_t*)(ws + WS_WOB),
           *WOM = (bf16_t*)(ws + WS_WOM), *WOUT = (bf16_t*)(ws + WS_WOUT), *WGU = (bf16_t*)(ws + WS_WGU), *WDN = (bf16_t*)(ws + WS_WDN), *MEMN = (bf16_t*)(ws + WS_MEMN),
           *KVMEM = (bf16_t*)(ws + WS_KVMEM), *MKB = (bf16_t*)(ws + WS_MKB), *MVT = (bf16_t*)(ws + WS_MVT), *KVS = (bf16_t*)(ws + WS_KVS), *KIS = (bf16_t*)(ws + WS_KIS),
           *KI = (bf16_t*)(ws + WS_KI), *H = (bf16_t*)(ws + WS_H), *QA = (bf16_t*)(ws + WS_QA), *KV = (bf16_t*)(ws + WS_KV), *QI = (bf16_t*)(ws + WS_QI),
           *UB = (bf16_t*)(ws + WS_UB), *QM = (bf16_t*)(ws + WS_QM), *PP = (bf16_t*)(ws + WS_PP), *GT = (bf16_t*)(ws + WS_G);
    float *WI = (float*)(ws + WS_WI), *KW32 = (float*)(ws + WS_KW32);
    unsigned char *KV8 = ws + WS_KV8, *QA8 = ws + WS_QA8, *KVS8 = ws + WS_KVS8;
    bf16_t* QL = (bf16_t*)(ws + WS_QL); bf16_t* WDN2 = (bf16_t*)(ws + WS_WDN2); float* PART = (float*)(ws + WS_QA);
    unsigned* ctl = (unsigned*)(ws + WS_CTL);
    bf16_t *ABR = H, *MBR = H + (size_t)MT * 512;
    float* Y = out + O_Y;
    volatile unsigned* xst = ctl + 8192 + 2 * blockIdx.x;
    __syncthreads();
    const XcdBarrier xbar = xcd_barrier_post(ctl + 4096, xst);

    {
        LAS float* scr = (LAS float*)(lds + wave * 16384);
        for (int it = gw; it < 8704; it += NGW) {
            int r = it; const float* W; int K, N, destN; bf16_t* WT; int kind;
            if (r < 2688) { kind = 0; W = w_in; K = 1024; N = 5160; destN = NIN; WT = WIN; }
            else if ((r -= 2688) < 512) { kind = 1; W = w_mem_kv; K = 1024; N = 1024; destN = 1024; WT = WMEM; }
            else if ((r -= 512) < 256) { kind = 1; W = w_oa; K = 512; N = 1024; destN = 1024; WT = WOA; }
            else if ((r -= 256) < 256) { kind = 1; W = w_ob; K = 512; N = 1024; destN = 1024; WT = WOB; }
            else if ((r -= 256) < 256) { kind = 1; W = w_om; K = 512; N = 1024; destN = 1024; WT = WOM; }
            else if ((r -= 256) < 512) { kind = 1; W = w_out; K = 1024; N = 1024; destN = 1024; WT = WOUT; }
            else if ((r -= 512) < 2816) { kind = 2; W = w_gate; K = 1024; N = DFF; destN = NGU; WT = WGU; }
            else { r -= 2816; kind = 1; W = w_down; K = DFF; N = 1024; destN = 1024; WT = WDN; }
            const int nblk = destN / 32, kb = r / nblk, nb = r % nblk, n = nb * 32 + (lane & 31);
            int col = n;
            if (kind == 0) col = map_in(n);
            else if (kind == 2) { const int j = n >> 8, rr = n & 255; if (rr >= 128) W = w_up; col = 128 * j + (rr & 127); }
            transpose_item(W, N, K, WT, kb * 64, nb * 32, col, scr, lane, kind == 2 ? g_ffn : nullptr);
        }
        for (int it = gw; it < 1408; it += NGW) {
            const int ks = it >> 7, rr = it & 127, kb = rr >> 5, nb = rr & 31;
            transpose_item(w_down + (size_t)ks * 256 * 1024, 1024, 256, WDN2 + (size_t)ks * 1024 * 256, kb * 64, nb * 32, nb * 32 + (lane & 31), scr, lane);
        }
        for (int idx = gw * 64 + lane; idx < 512 * 256; idx += NGW * 64) {
            const int n = idx >> 8, kk = idx & 255, g = n >> 7, e = n & 127;
            const float v = ((kk >> 7) == (g & 1)) ? w_pool[(size_t)(g * 128 + (kk & 127)) * 128 + e] : 0.f;
            WPOOL[idx] = (bf16_t)(cvt_pk_bf16(v, 0.f) & 0xffffu);
        }
        {
            f32x4 gg[4];
#pragma unroll
            for (int j = 0; j < 4; ++j) gg[j] = ((const f32x4*)g_mix)[lane + 64 * j];
            f32x4 va[4], vb[4], na[4], nb[4];
            int r = gw;
#define XROW(rr_) ((rr_) < MP ? x_prompt + (size_t)(rr_) * 1024 : x_sample + (size_t)((rr_) - MP) * 1024)
            if (r < MT) { const float* xa = XROW(r); const int r1 = r + NGW; const float* xb = r1 < MT ? XROW(r1) : xa;
#pragma unroll
                for (int j = 0; j < 4; ++j) { va[j] = ((const f32x4*)xa)[lane + 64 * j]; vb[j] = ((const f32x4*)xb)[lane + 64 * j]; } }
            for (; r < MT; r += 2 * NGW) {
                const int r1 = r + NGW; const bool has1 = r1 < MT;
                const int rn = r + 2 * NGW;
                if (rn < MT) { const float* xa = XROW(rn); const int rn1 = rn + NGW; const float* xb = rn1 < MT ? XROW(rn1) : xa;
#pragma unroll
                    for (int j = 0; j < 4; ++j) { na[j] = ((const f32x4*)xa)[lane + 64 * j]; nb[j] = ((const f32x4*)xb)[lane + 64 * j]; } }
                float sa = 0.f, sb = 0.f;
#pragma unroll
                for (int j = 0; j < 4; ++j) { sa += (va[j].x * va[j].x + va[j].y * va[j].y) + (va[j].z * va[j].z + va[j].w * va[j].w); sb += (vb[j].x * vb[j].x + vb[j].y * vb[j].y) + (vb[j].z * vb[j].z + vb[j].w * vb[j].w); }
                const float ra = rsqrtf(wave_sum(sa) * (1.f / 1024.f) + EPS), rb = rsqrtf(wave_sum(sb) * (1.f / 1024.f) + EPS);
#pragma unroll
                for (int j = 0; j < 4; ++j) {
                    u32x2 w; w.x = cvt_pk_bf16(va[j].x * ra * gg[j].x, va[j].y * ra * gg[j].y); w.y = cvt_pk_bf16(va[j].z * ra * gg[j].z, va[j].w * ra * gg[j].w);
                    *(u32x2*)(H + (size_t)r * 1024 + 4 * lane + 256 * j) = w;
                    if (has1) { u32x2 w2; w2.x = cvt_pk_bf16(vb[j].x * rb * gg[j].x, vb[j].y * rb * gg[j].y); w2.y = cvt_pk_bf16(vb[j].z * rb * gg[j].z, vb[j].w * rb * gg[j].w);
                        *(u32x2*)(H + (size_t)r1 * 1024 + 4 * lane + 256 * j) = w2; } }
#pragma unroll
                for (int j = 0; j < 4; ++j) { va[j] = na[j]; vb[j] = nb[j]; }
            }
#undef XROW
        }
        for (int r = gw; r < 2048; r += NGW) rms_row_1024(mem_prompt + (size_t)r * 1024, g_mem, MEMN + (size_t)r * 1024, lane);
        for (int r = gw; r < 16 * 1024; r += NGW) {
            const int b = r >> 10, s = r & 1023;
            const float* src = (lane < 32) ? cache_a_k + (size_t)r * 128 + 4 * lane : cache_a_v + (size_t)r * 128 + 4 * (lane - 32);
            const f32x4 v = *(const f32x4*)src; u32x2 w; w.x = cvt_pk_bf16(v.x, v.y); w.y = cvt_pk_bf16(v.z, v.w);
            { int f8 = __builtin_amdgcn_cvt_pk_fp8_f32(v.x, v.y, 0, false); f8 = __builtin_amdgcn_cvt_pk_fp8_f32(v.z, v.w, f8, true);
              *(unsigned*)(KVS8 + (size_t)(b * SKEYS + s) * 256 + 4 * lane) = (unsigned)f8; }
        }
        for (int idx = gw * 64 + lane; idx < 16 * 1024 * 16; idx += NGW * 64) {
            const int r = idx >> 4, c2 = idx & 15, b = r >> 10, s = r & 1023;
            const float v0 = cache_idx_k[(size_t)r * 32 + 2 * c2], v1 = cache_idx_k[(size_t)r * 32 + 2 * c2 + 1];
            *(unsigned*)(KIS + (size_t)(b * SKEYS + s) * 32 + 2 * c2) = cvt_pk_bf16(v0, v1);
        }
        for (int i0 = gw * 64 + lane; i0 < 16 * 256 * 256; i0 += 4 * NGW * 64) {
            f32x4 va[2]; float v0[4], v1[4];
#pragma unroll
            for (int j = 0; j < 4; ++j) { const int idx = i0 + j * NGW * 64; const bool ok = idx < 16 * 256 * 256; v0[j] = ok ? cache_mem_k[(size_t)idx * 2] : 0.f; v1[j] = ok ? cache_mem_k[(size_t)idx * 2 + 1] : 0.f; }
#pragma unroll
            for (int j = 0; j < 4; ++j) { const int idx = i0 + j * NGW * 64; if (idx < 16 * 256 * 256) *(unsigned*)(MKB + (size_t)2048 * 512 + (size_t)idx * 2) = cvt_pk_bf16(v0[j], v1[j]); }
            (void)va;
        }
        for (int it = gw; it < 16 * 8 * 8; it += NGW) {
            const int b = it >> 6, kb = (it >> 3) & 7, hb = it & 7;
            float tv[32];
#pragma unroll
            for (int k = 0; k < 32; ++k) tv[k] = cache_mem_v[((size_t)(b * 256 + kb * 32 + k)) * 512 + hb * 64 + lane];
#pragma unroll
            for (int k = 0; k < 32; ++k) scr[k * 65 + lane] = tv[k];
            asm volatile("s_waitcnt lgkmcnt(0)" ::: "memory");
#pragma unroll 4
            for (int h = 0; h < 64; h += 4) { const int hh = h + (lane >> 4), k2 = (lane & 15) * 2;
                const float a0 = scr[k2 * 65 + hh], a1 = scr[(k2 + 1) * 65 + hh];
                *(unsigned*)(MVT + ((size_t)(8 + b) * 512 + hb * 64 + hh) * 256 + kb * 32 + k2) = cvt_pk_bf16(a0, a1); }
            asm volatile("s_waitcnt lgkmcnt(0)" ::: "memory");
        }
    }
    grid.sync();

    {
        pg8::StaticOrder S; S.init(MT, NIN, G, (int)blockIdx.x);
        pg8::Gemm g{H, WIN, MT, NIN, 1024, 1024, 1024, 0, nullptr, nullptr, nullptr, nullptr, 0};
        Epi<EP_INPROJ> E; E.p = EpiArgs{}; E.p.QA = QA; E.p.KV = KV; E.p.QI = QI; E.p.UB = UB; E.p.QM = QM; E.p.G = GT; E.p.KW32 = KW32;
        pg8::gemm_phase(lds, g, S, E);
        pg8::StaticOrder S2; S2.init(2048, 1024, G, (int)blockIdx.x >= G - 32 ? (int)blockIdx.x - (G - 32) : (1 << 20));
        pg8::Gemm g2{MEMN, WMEM, 2048, 1024, 1024, 1024, 1024, 0, nullptr, nullptr, nullptr, nullptr, 0};
        Epi<EP_BF16> E2; E2.p = EpiArgs{}; E2.p.O = KVMEM; E2.p.ldc = 1024; E2.p.cs = nullptr;
        pg8::gemm_phase(lds, g2, S2, E2);
    }
    xcd_barrier(xbar);

    float inv64[8], inv16q[4];
    {
        const int j8h = lane & 7;
#pragma unroll
        for (int e = 0; e < 8; ++e) inv64[e] = powf(10000.0f, -(float)(8 * (j8h & 3) + e) * (1.0f / 32.0f));
#pragma unroll
        for (int e = 0; e < 4; ++e) inv16q[e] = powf(10000.0f, -(float)(4 * (j8h & 3) + e) * (1.0f / 16.0f));
    }
    const float inv16k = powf(10000.0f, -(float)(lane & 15) * (1.0f / 16.0f));
    float gqa_[8], gka_[8], gqm_[8];
#pragma unroll
    for (int e = 0; e < 8; ++e) { gqa_[e] = g_qa[8 * (lane & 7) + e]; gka_[e] = g_ka[8 * (lane & 7) + e]; gqm_[e] = g_qm[8 * (lane & 15) + e]; }
    const float gkidx_ = g_kidx[lane & 31];
    for (int row = gw; row < MT; row += NGW) {
        const bool samp = row >= MP; const int rs = row - MP;
        int b, t, pos; if (!samp) { b = row >> 13; t = row & 8191; pos = t; } else { b = rs >> 6; t = rs & 63; pos = 1024 + t; }
        const float fpos = (float)pos;
        const int j8 = lane & 7;
        const u32x4 qa_raw = *(const u32x4*)(QA + (size_t)row * 512 + 8 * lane);
        u32x4 kv_raw = (u32x4){0u, 0u, 0u, 0u}; if (lane < 32) kv_raw = *(const u32x4*)(KV + (size_t)row * 256 + 8 * lane);
        const u32x2 qi_raw = *(const u32x2*)(QI + (size_t)row * 256 + 4 * lane);
        const float kw_x = KW32[(size_t)row * 64 + lane];
        const u32x4 qm_raw = *(const u32x4*)(QM + (size_t)row * 512 + 8 * lane);
        const int pw_ = 2 << (lane >> 4);
        u32x4 ubr[16];
#pragma unroll
        for (int k = 0; k < 16; ++k) { ubr[k] = (u32x4){0u, 0u, 0u, 0u}; if (k < pw_ && t - k >= 0) ubr[k] = *(const u32x4*)(UB + (size_t)(row - k) * 512 + 8 * lane); }
        float c64[8], s64[8];
#pragma unroll
        for (int e = 0; e < 8; ++e) sincos_red(fpos * inv64[e], s64[e], c64[e]);
        {
            float v[8]; unpack8(qa_raw, v);
            float ss = 0.f;
#pragma unroll
            for (int e = 0; e < 8; ++e) ss += v[e] * v[e];
            ss += __shfl_xor(ss, 1); ss += __shfl_xor(ss, 2); ss += __shfl_xor(ss, 4);
            const float rstd = rsqrtf(ss * (1.f / 64.f) + EPS);
            float o[8];
#pragma unroll
            for (int e = 0; e < 8; ++e) { v[e] = v[e] * rstd * gqa_[e]; }
#pragma unroll
            for (int e = 0; e < 8; ++e) { const float pv = __shfl_xor(v[e], 4); o[e] = (j8 < 4) ? v[e] * c64[e] - pv * s64[e] : v[e] * c64[e] + pv * s64[e]; }
            *(u32x2*)(QA8 + (size_t)row * 512 + 8 * lane) = pack8_fp8(o);
        }
        {
            float v[8]; unpack8(kv_raw, v);
            float ss = 0.f;
#pragma unroll
            for (int e = 0; e < 8; ++e) ss += v[e] * v[e];
            ss += __shfl_xor(ss, 1); ss += __shfl_xor(ss, 2); ss += __shfl_xor(ss, 4);
            const float rstd = rsqrtf(ss * (1.f / 64.f) + EPS);
            float kn[8], o[8];
#pragma unroll
            for (int e = 0; e < 8; ++e) kn[e] = v[e] * rstd * gka_[e];
#pragma unroll
            for (int e = 0; e < 8; ++e) { const float pv = __shfl_xor(kn[e], 4); o[e] = (j8 < 4) ? kn[e] * c64[e] - pv * s64[e] : kn[e] * c64[e] + pv * s64[e]; }
            float* ok = samp ? out + O_AKS + (size_t)rs * 128 : out + O_AKP + (size_t)row * 128;
            float* ov = samp ? out + O_AVS + (size_t)rs * 128 : out + O_AVP + (size_t)row * 128;
            if (lane < 16) {
                { const u32x2 w8 = pack8_fp8(o); *(u32x2*)(KV8 + (size_t)row * 256 + 8 * lane) = w8; if (samp) *(u32x2*)(KVS8 + (size_t)(b * SKEYS + 1024 + t) * 256 + 8 * lane) = w8; }
                *(f32x4*)(ok + 8 * lane) = (f32x4){o[0], o[1], o[2], o[3]}; *(f32x4*)(ok + 8 * lane + 4) = (f32x4){o[4], o[5], o[6], o[7]};
            } else if (lane < 32) {
                { const u32x2 w8 = pack8_fp8(v); *(u32x2*)(KV8 + (size_t)row * 256 + 8 * lane) = w8; if (samp) *(u32x2*)(KVS8 + (size_t)(b * SKEYS + 1024 + t) * 256 + 8 * lane) = w8; }
                *(f32x4*)(ov + 8 * (lane - 16)) = (f32x4){v[0], v[1], v[2], v[3]}; *(f32x4*)(ov + 8 * (lane - 16) + 4) = (f32x4){v[4], v[5], v[6], v[7]};
            }
        }
        {
            const u32x2 qv = qi_raw;
            float v[4] = {bflo(qv.x), bfhi(qv.x), bflo(qv.y), bfhi(qv.y)}, o[4];
#pragma unroll
            for (int e = 0; e < 4; ++e) { float sn, cs; sincos_red(fpos * inv16q[e], sn, cs);
                const float pv = __shfl_xor(v[e], 4); o[e] = (j8 < 4) ? v[e] * cs - pv * sn : v[e] * cs + pv * sn; }
            u32x2 w; w.x = cvt_pk_bf16(o[0], o[1]); w.y = cvt_pk_bf16(o[2], o[3]);
            *(u32x2*)(QI + (size_t)row * 256 + 4 * lane) = w;
            {
                const float wh = __shfl(kw_x, 32 + (lane >> 3)) * (0.0625f * 0.5f);
                float ql[4] = {wh * bflo(w.x), wh * bfhi(w.x), wh * bflo(w.y), wh * bfhi(w.y)};
#pragma unroll
                for (int off = 8; off < 64; off <<= 1) {
#pragma unroll
                    for (int e = 0; e < 4; ++e) ql[e] += __shfl_xor(ql[e], off); }
                if (lane < 8) { u32x2 wq; wq.x = cvt_pk_bf16(ql[0], ql[1]); wq.y = cvt_pk_bf16(ql[2], ql[3]); *(u32x2*)(QL + (size_t)row * 32 + 4 * lane) = wq; }
            }
        }
        {
            const float x = kw_x;
            float ss = (lane < 32) ? x * x : 0.f;
            ss += __shfl_xor(ss, 1); ss += __shfl_xor(ss, 2); ss += __shfl_xor(ss, 4); ss += __shfl_xor(ss, 8); ss += __shfl_xor(ss, 16);
            const float rstd = rsqrtf(ss * (1.f / 32.f) + EPS);
            const float yv = x * rstd * gkidx_;
            float sn, cs; sincos_red(fpos * inv16k, sn, cs);
            const float pv = __shfl_xor(yv, 16);
            const float o = ((lane & 31) < 16) ? yv * cs - pv * sn : yv * cs + pv * sn;
            const unsigned ob = cvt_pk_bf16(o, 0.f) & 0xffffu;
            if (lane < 32) {
                KI[(size_t)row * 32 + lane] = (bf16_t)ob;
                if (samp) { KIS[(size_t)(b * SKEYS + 1024 + t) * 32 + lane] = (bf16_t)ob; out[O_IKS + (size_t)rs * 32 + lane] = o; }
                else out[O_IKP + (size_t)row * 32 + lane] = o;
            } else if (lane < 40) WI[(size_t)row * 8 + (lane - 32)] = x * 0.0625f;
        }
        {
            float v[8]; unpack8(qm_raw, v);
            float ss = 0.f;
#pragma unroll
            for (int e = 0; e < 8; ++e) ss += v[e] * v[e];
            ss += __shfl_xor(ss, 1); ss += __shfl_xor(ss, 2); ss += __shfl_xor(ss, 4); ss += __shfl_xor(ss, 8);
            const float rstd = rsqrtf(ss * (1.f / 128.f) + EPS);
#pragma unroll
            for (int e = 0; e < 8; ++e) v[e] = v[e] * rstd * gqm_[e];
            *(u32x4*)(QM + (size_t)row * 512 + 8 * lane) = pack8(v);
        }
        {
            const int c0 = 8 * lane, gi = lane >> 4, w = 2 << gi;
            float u[8], sum[8];
            unpack8(ubr[0], u);
#pragma unroll
            for (int e = 0; e < 8; ++e) sum[e] = u[e];
#pragma unroll
            for (int k = 1; k < 16; ++k) { float x[8]; unpack8(ubr[k], x);
#pragma unroll
                for (int e = 0; e < 8; ++e) sum[e] += x[e]; }
            if (samp && t < 15) {
                for (int k = 1; k < 16; ++k) {
                    const int tt = t - k;
                    if (k < w && tt < 0) { const float* cp = cache_pool + (size_t)(b * 15 + 15 + tt) * 512 + c0; const f32x4 x0 = *(const f32x4*)cp, x1 = *(const f32x4*)(cp + 4);
                        sum[0] += x0.x; sum[1] += x0.y; sum[2] += x0.z; sum[3] += x0.w; sum[4] += x1.x; sum[5] += x1.y; sum[6] += x1.z; sum[7] += x1.w; }
                }
            }
            const int cnt = samp ? w : (w < t + 1 ? w : t + 1);
            const float ic = 1.0f / (float)cnt;
            float o[8];
#pragma unroll
            for (int e = 0; e < 8; ++e) o[e] = sum[e] * ic - u[e];
            *(u32x4*)(PP + (size_t)row * 512 + c0) = pack8(o);
            float* po = nullptr;
            if (!samp && t >= 8177) po = out + O_PLP + (size_t)(b * 15 + (t - 8177)) * 512 + c0;
            if (samp && t >= 49) po = out + O_PLS + (size_t)(b * 15 + (t - 49)) * 512 + c0;
            if (po) { *(f32x4*)po = (f32x4){u[0], u[1], u[2], u[3]}; *(f32x4*)(po + 4) = (f32x4){u[4], u[5], u[6], u[7]}; }
        }
    }
    for (int r = gw; r < 2048; r += NGW) {
        float v[8]; unpack8(*(const u32x4*)(KVMEM + (size_t)r * 1024 + 8 * lane), v);
        float ss = 0.f;
#pragma unroll
        for (int e = 0; e < 8; ++e) ss += v[e] * v[e];
        ss += __shfl_xor(ss, 1); ss += __shfl_xor(ss, 2); ss += __shfl_xor(ss, 4); ss += __shfl_xor(ss, 8);
        const float rstd = rsqrtf(ss * (1.f / 128.f) + EPS);
#pragma unroll
        for (int e = 0; e < 8; ++e) v[e] = v[e] * rstd * g_km[8 * (lane & 15) + e];
        *(u32x4*)(MKB + (size_t)r * 512 + 8 * lane) = pack8(v);
        float* mk = out + O_MKP + (size_t)r * 512 + 8 * lane;
        *(f32x4*)mk = (f32x4){v[0], v[1], v[2], v[3]}; *(f32x4*)(mk + 4) = (f32x4){v[4], v[5], v[6], v[7]};
        float x[8]; const u32x4 xr = *(const u32x4*)(KVMEM + (size_t)r * 1024 + 512 + 8 * lane); unpack8(xr, x);
        float* mv = out + O_MVP + (size_t)r * 512 + 8 * lane;
        *(f32x4*)mv = (f32x4){x[0], x[1], x[2], x[3]}; *(f32x4*)(mv + 4) = (f32x4){x[4], x[5], x[6], x[7]};
        const int b = r >> 8, key = r & 255; const unsigned xs[4] = {xr.x, xr.y, xr.z, xr.w};
#pragma unroll
        for (int e = 0; e < 8; ++e) MVT[((size_t)b * 512 + 8 * lane + e) * 256 + key] = (bf16_t)((e & 1) ? (xs[e >> 1] >> 16) : (xs[e >> 1] & 0xffffu));
    }
    xcd_barrier(xbar);

    {
        pg8::StaticOrder S; S.init(MT, 512, G, (int)blockIdx.x);
        pg8::Gemm g{PP, WPOOL, MT, 512, 256, 512, 256, 256, nullptr, nullptr, nullptr, nullptr, 0};
        Epi<EP_BF16> E; E.p = EpiArgs{}; E.p.O = UB; E.p.ldc = 512; E.p.cs = s_pool;
        pg8::gemm_phase(lds, g, S, E);
    }
    {
        LAS unsigned* hist = (LAS unsigned*)(lds + wave * 20480);
        LAS unsigned short* selb = (LAS unsigned short*)(lds + wave * 20480);
        LAS unsigned* candk = (LAS unsigned*)(lds + wave * 20480 + 4096);
        LAS unsigned short* candi = (LAS unsigned short*)(lds + wave * 20480 + 6144);
        LAS unsigned char* wbuf = lds + wave * 20480 + 4096;
        const int hf = lane >> 5, l31 = lane & 31;
        const unsigned lmask = (1u << l31) - 1u;
        const int myq = (int)(__builtin_amdgcn_s_getreg((3 << 11) | 20) & 7u);
#pragma unroll 1
        for (int kq = 0; kq < 8; ++kq) {
        const int qb = (myq + kq) & 7;
        for (;;) {
            int item = 0; if (lane == 0) item = (int)atomicAdd(ctl + 64 + 64 * qb, 1u);
            item = __builtin_amdgcn_readfirstlane(item);
            if (item >= 1040) break;
            int n, qrow0; const bf16_t *kib, *kvb; const unsigned char* kv8;
            if (item < 1024) { const int c = 127 - (item >> 3), sg = item & 7;
                n = 64 * (c + 1); qrow0 = qb * 8192 + c * 64 + sg * 8; kib = KI + (size_t)qb * 8192 * 32; kvb = KV + (size_t)qb * 8192 * 256; kv8 = KV8 + (size_t)qb * 8192 * 256; }
            else { const int j = item - 1024, sb = 2 * qb + (j >> 3), sg = j & 7;
                n = SKEYS; qrow0 = MP + sb * 64 + sg * 8; kib = KIS + (size_t)sb * SKEYS * 32; kvb = KVS + (size_t)sb * SKEYS * 256; kv8 = KVS8 + (size_t)sb * SKEYS * 256; }
            const int ntile = (n < 256 ? n : 256) >> 4;
            bool fast = false;
            if (n <= 256) {
                for (int i = lane; i < 2048; i += 64) selb[i] = (unsigned short)(i & 255);
                fast = true;
            } else {
                bf16x8 A00, A01, A10, A11; float wa[8], wb[8], wc_[8], wd[8];
                { const int r = l31, qq = 2 * ((r & 7) >> 2) + (r >> 4), hd = 4 * ((r >> 3) & 1) + (r & 3);
                  const bf16_t* qp = QI + (size_t)(qrow0 + qq) * 256 + hd * 32 + 8 * hf;
                  A00 = *(const bf16x8*)qp; A01 = *(const bf16x8*)(qp + 16); A10 = *(const bf16x8*)(qp + 4 * 256); A11 = *(const bf16x8*)(qp + 4 * 256 + 16);
                  const float* wp0 = WI + (size_t)(qrow0 + 2 * hf) * 8;
#pragma unroll
                  for (int e = 0; e < 8; ++e) { wa[e] = 0.5f * wp0[e]; wb[e] = 0.5f * wp0[8 + e]; wc_[e] = 0.5f * wp0[32 + e]; wd[e] = 0.5f * wp0[40 + e]; } }
                bf16x8 AL0, AL1;
                { u32x4 z0 = (u32x4){0u, 0u, 0u, 0u}, z1 = z0;
                  if (l31 < 8) { const int rg = l31 & 3, hr = l31 >> 2, qq = rg < 2 ? 2 * hr + rg : 4 + 2 * hr + (rg - 2);
                      const bf16_t* lp = QL + (size_t)(qrow0 + qq) * 32 + 8 * hf; z0 = *(const u32x4*)lp; z1 = *(const u32x4*)(lp + 16); }
                  AL0 = __builtin_bit_cast(bf16x8, z0); AL1 = __builtin_bit_cast(bf16x8, z1); }
#define SCORE8(b0_, b1_, sa_, sb_, sc_, sd_) do { \
                    f32x16 ac_ = {0.f,0.f,0.f,0.f,0.f,0.f,0.f,0.f,0.f,0.f,0.f,0.f,0.f,0.f,0.f,0.f}, ad_ = ac_; \
                    f32x16 al_ = ac_; \
                    ac_ = MFMA32(A00, b0_, ac_); ad_ = MFMA32(A10, b0_, ad_); al_ = MFMA32(AL0, b0_, al_); ac_ = MFMA32(A01, b1_, ac_); ad_ = MFMA32(A11, b1_, ad_); al_ = MFMA32(AL1, b1_, al_); \
                    sa_ = al_[0]; sb_ = al_[1]; sc_ = al_[2]; sd_ = al_[3];     \
                    _Pragma("unroll") for (int e_ = 0; e_ < 8; ++e_) { sa_ = fmaf(wa[e_], fabsf(ac_[e_]), sa_); sb_ = fmaf(wb[e_], fabsf(ac_[8 + e_]), sb_); \
                                                                      sc_ = fmaf(wc_[e_], fabsf(ad_[e_]), sc_); sd_ = fmaf(wd[e_], fabsf(ad_[8 + e_]), sd_); } } while (0)
#define KLOAD(s_, r0_, r1_) do { const bf16_t* kp_ = kib + (size_t)((s_) + l31) * 32 + 8 * hf; r0_ = *(const bf16x8*)kp_; r1_ = *(const bf16x8*)(kp_ + 16); } while (0)
#define BINOF(s_, lo_, sc_) ((int)fminf(fmaxf(((s_) - (lo_)) * (sc_), 0.f), 1023.f))
                float lo0, lo1, lo2, lo3, bs0, bs1, bs2, bs3;
                {
                    bf16x8 b0, b1, c0, c1; KLOAD(0, b0, b1); KLOAD(32, c0, c1);
                    float s0, s1, s2, s3, t0, t1, t2, t3; SCORE8(b0, b1, s0, s1, s2, s3); SCORE8(c0, c1, t0, t1, t2, t3);
                    float mn0 = fminf(s0, t0), mn1 = fminf(s1, t1), mn2 = fminf(s2, t2), mn3 = fminf(s3, t3);
                    float mx0 = fmaxf(s0, t0), mx1 = fmaxf(s1, t1), mx2 = fmaxf(s2, t2), mx3 = fmaxf(s3, t3);
#pragma unroll
                    for (int o = 1; o < 32; o <<= 1) {
                        mn0 = fminf(mn0, __shfl_xor(mn0, o)); mn1 = fminf(mn1, __shfl_xor(mn1, o)); mn2 = fminf(mn2, __shfl_xor(mn2, o)); mn3 = fminf(mn3, __shfl_xor(mn3, o));
                        mx0 = fmaxf(mx0, __shfl_xor(mx0, o)); mx1 = fmaxf(mx1, __shfl_xor(mx1, o)); mx2 = fmaxf(mx2, __shfl_xor(mx2, o)); mx3 = fmaxf(mx3, __shfl_xor(mx3, o)); }
                    const float r0 = mx0 - mn0, r1 = mx1 - mn1, r2 = mx2 - mn2, r3 = mx3 - mn3;
                    lo0 = mn0 - 0.5f * r0; lo1 = mn1 - 0.5f * r1; lo2 = mn2 - 0.5f * r2; lo3 = mn3 - 0.5f * r3;
                    bs0 = r0 > 0.f ? 511.f / r0 : 0.f; bs1 = r1 > 0.f ? 511.f / r1 : 0.f; bs2 = r2 > 0.f ? 511.f / r2 : 0.f; bs3 = r3 > 0.f ? 511.f / r3 : 0.f;
                }
                { u32x4 z = (u32x4){0u, 0u, 0u, 0u};
#pragma unroll
                  for (int i = 0; i < 16; ++i) *(LAS u32x4*)(hist + 4 * (lane + 64 * i)) = z; }
                {
                    bf16x8 b0, b1; KLOAD(0, b0, b1);
                    for (int s0 = 0; s0 < n; s0 += 32) {
                        bf16x8 nb0, nb1; KLOAD((s0 + 32 < n) ? s0 + 32 : s0, nb0, nb1);
                        float s0_, s1_, s2_, s3_; SCORE8(b0, b1, s0_, s1_, s2_, s3_);
                        const int i0 = BINOF(s0_, lo0, bs0), i1 = BINOF(s1_, lo1, bs1), i2 = BINOF(s2_, lo2, bs2), i3 = BINOF(s3_, lo3, bs3);
                        __hip_atomic_fetch_add(hist + (2 * hf) * 512 + (i0 >> 1), 1u << (16 * (i0 & 1)), __ATOMIC_RELAXED, __HIP_MEMORY_SCOPE_WORKGROUP);
                        __hip_atomic_fetch_add(hist + (2 * hf + 1) * 512 + (i1 >> 1), 1u << (16 * (i1 & 1)), __ATOMIC_RELAXED, __HIP_MEMORY_SCOPE_WORKGROUP);
                        __hip_atomic_fetch_add(hist + (4 + 2 * hf) * 512 + (i2 >> 1), 1u << (16 * (i2 & 1)), __ATOMIC_RELAXED, __HIP_MEMORY_SCOPE_WORKGROUP);
                        __hip_atomic_fetch_add(hist + (5 + 2 * hf) * 512 + (i3 >> 1), 1u << (16 * (i3 & 1)), __ATOMIC_RELAXED, __HIP_MEMORY_SCOPE_WORKGROUP);
                        b0 = nb0; b1 = nb1;
                    }
                }
                int bins[8], abv[8], inb[8]; int worst = 0;
#pragma unroll
                for (int qq = 0; qq < 8; ++qq) { scan_hist1024(hist + qq * 512, 256, lane, bins[qq], abv[qq], inb[qq]); worst = inb[qq] > worst ? inb[qq] : worst; }
                fast = (worst <= 64);
                if (fast) {
                    const int B0 = hf ? bins[2] : bins[0], B1 = hf ? bins[3] : bins[1], B2 = hf ? bins[6] : bins[4], B3 = hf ? bins[7] : bins[5];
                    int c0 = 0, c1 = 0, c2 = 0, c3 = 0, d0 = 0, d1 = 0, d2 = 0, d3 = 0;
                    bf16x8 b0, b1; KLOAD(0, b0, b1);
                    for (int s0 = 0; s0 < n; s0 += 32) {
                        bf16x8 nb0, nb1; KLOAD((s0 + 32 < n) ? s0 + 32 : s0, nb0, nb1);
                        float s0_, s1_, s2_, s3_; SCORE8(b0, b1, s0_, s1_, s2_, s3_);
#define SELSTEP(sv_, lo_, bs_, Bq_, cq_, dq_, slot_) do { const int bi_ = BINOF(sv_, lo_, bs_); const bool tk_ = bi_ > Bq_, cd_ = bi_ == Bq_; \
                            const unsigned long long m1_ = __ballot(tk_), m2_ = __ballot(cd_); const unsigned h1_ = hf ? (unsigned)(m1_ >> 32) : (unsigned)m1_, h2_ = hf ? (unsigned)(m2_ >> 32) : (unsigned)m2_; \
                            const int p1_ = cq_ + (int)__popc(h1_ & lmask), p2_ = dq_ + (int)__popc(h2_ & lmask); cq_ += (int)__popc(h1_); dq_ += (int)__popc(h2_); \
                            if (tk_ && p1_ < 256) selb[(slot_) * 256 + p1_] = (unsigned short)(s0 + l31); \
                            if (cd_ && p2_ < 64) { const unsigned u_ = __float_as_uint(sv_); candk[(slot_) * 64 + p2_] = (u_ & 0x80000000u) ? ~u_ : (u_ | 0x80000000u); candi[(slot_) * 64 + p2_] = (unsigned short)(s0 + l31); } } while (0)
                        SELSTEP(s0_, lo0, bs0, B0, c0, d0, 2 * hf);
                        SELSTEP(s1_, lo1, bs1, B1, c1, d1, 2 * hf + 1);
                        SELSTEP(s2_, lo2, bs2, B2, c2, d2, 4 + 2 * hf);
                        SELSTEP(s3_, lo3, bs3, B3, c3, d3, 5 + 2 * hf);
#undef SELSTEP
                        b0 = nb0; b1 = nb1;
                    }
#pragma unroll
                    for (int qq = 0; qq < 8; ++qq) {
                        const int m = inb[qq], r = 256 - abv[qq];
                        const unsigned k = (lane < m) ? candk[qq * 64 + lane] : 0u; const int ix = (lane < m) ? (int)candi[qq * 64 + lane] : 0;
                        int rank = 0;
                        for (int j = 0; j < m; ++j) { const unsigned kj = (unsigned)__shfl((int)k, j); const int ij = __shfl(ix, j); rank += ((kj > k) || (kj == k && ij < ix)) ? 1 : 0; }
                        const bool tk = (lane < m) && (rank < r);
                        const unsigned long long mm = __ballot(tk);
                        const int pos = abv[qq] + (int)__popcll(mm & ((1ull << lane) - 1ull));
                        if (tk && pos < 256) selb[qq * 256 + pos] = (unsigned short)ix;
                    }
                }
#undef SCORE8
#undef KLOAD
#undef BINOF
            }
            if (fast) {
#pragma unroll 1
                for (int hq = 0; hq < 4; ++hq) sparse_attn_lds<2>(QA8, kv8, ABR, qrow0 + 2 * hq, selb + 2 * hq * 256, wbuf, ntile >> 1, lane);
            } else {
#pragma unroll 1
                for (int grp = 0; grp < 2; ++grp) {
                    radix_select4(QI, WI, kib, n, qrow0 + 4 * grp, hist, selb, lane);
#pragma unroll 1
                    for (int hq = 0; hq < 2; ++hq) sparse_attn_lds<2>(QA8, kv8, ABR, qrow0 + 4 * grp + 2 * hq, selb + 2 * hq * 256, wbuf, ntile >> 1, lane);
                }
            }
        }
        }
    }
    for (;;) {
        int it0 = 0; if (lane == 0) it0 = (int)atomicAdd(ctl + 32, 2u);
        it0 = __builtin_amdgcn_readfirstlane(it0);
        if (it0 >= (MT / 16) * 4) break;
#pragma unroll 1
        for (int j = 0; j < 2; ++j) { const int it = it0 + j; const int h = it & 3, r0 = (it >> 2) * 16;
            const int bb = r0 < MP ? (r0 >> 13) : 8 + ((r0 - MP) >> 6);
            mem_attn_item(QM, MKB + (size_t)bb * 256 * 512, MVT + ((size_t)bb * 512 + h * 128) * 256, MBR, r0, h, lane); }
    }
    xcd_barrier(xbar);
    {
        pg8::ChainOrder3 S; S.base.init(MT, 1024, G, (int)blockIdx.x);
        pg8::Gemm g{ABR, WOA, MT, 1024, 512, 512, 512, 0, UB, MBR, WOB, WOM, 0};
        Epi<EP_CHAIN> E; E.p = EpiArgs{}; E.p.G = GT;
        pg8::gemm_phase(lds, g, S, E);
    }
    xcd_barrier(xbar);
    {
        pg8::StaticOrder S; S.init(MT, 1024, G, (int)blockIdx.x);
        pg8::Gemm g{GT, WOUT, MT, 1024, 1024, 3072, 1024, 0, nullptr, nullptr, nullptr, nullptr, 0};
        Epi<EP_WOUT> E; E.p = EpiArgs{}; E.p.Y = Y; E.p.xp = x_prompt; E.p.xs = x_sample; E.p.XG = H; E.p.SS = KW32; E.p.gf = g_ffn;
        pg8::gemm_phase(lds, g, S, E);
    }
    xcd_barrier(xbar);
    {
        pg8::StaticOrder S; S.init(MT, NGU, G, (int)blockIdx.x);
        pg8::Gemm g{H, WGU, MT, NGU, 1024, 1024, 1024, 0, nullptr, nullptr, nullptr, nullptr, 0};
        Epi<EP_UP> E; E.p = EpiArgs{}; E.p.HID = GT; E.p.SS = KW32;
        pg8::gemm_phase(lds, g, S, E);
    }
    xcd_barrier(xbar);
    {
        pg8::StaticOrder S; S.init(MP, 1024, G, (int)blockIdx.x);
        pg8::Gemm g{GT, WDN, MP, 1024, DFF, DFF, DFF, 0, nullptr, nullptr, nullptr, nullptr, 0};
        Epi<EP_DOWN> E; E.p = EpiArgs{}; E.p.Y = Y; E.p.XG = H;
        pg8::gemm_phase(lds, g, S, E);
        pg8::StaticOrder S2; S2.init(MS, 11 * 1024, G, (int)blockIdx.x);
        pg8::Gemm g2{GT + (size_t)MP * DFF, WDN2, MS, 11 * 1024, 256, DFF, 256, 256, nullptr, nullptr, nullptr, nullptr, 2};
        Epi<EP_DOWN_PART> E2; E2.p = EpiArgs{}; E2.p.Y = PART;
        pg8::gemm_phase(lds, g2, S2, E2);
    }
    xcd_barrier(xbar);
    for (int i = (gw * 64 + lane) * 4; i < MS * 1024; i += NGW * 64 * 4) {
        const int r = i >> 10, cidx = i & 1023;
        const u32x2 xb = *(const u32x2*)(H + (size_t)(MP + r) * 1024 + cidx);
        f32x4 acc4 = (f32x4){bflo(xb.x), bfhi(xb.x), bflo(xb.y), bfhi(xb.y)};
#pragma unroll
        for (int ks = 0; ks < 11; ++ks) acc4 = acc4 + *(const f32x4*)(PART + ((size_t)ks * 1024 + r) * 1024 + cidx);
        *(f32x4*)(Y + (size_t)(MP + r) * 1024 + cidx) = acc4;
    }
}

extern "C" void kernel_launch(void* const* d_in, const int* in_sizes, int n_in, void* d_out, int out_size, void* d_ws, size_t ws_size, hipStream_t stream) {
    static int grid = 0;
    if (grid == 0) {
        if (n_in != 28 || ws_size < WS_END) { fprintf(stderr, "kernel_launch: unexpected inputs (n_in %d, ws %zu)\n", n_in, ws_size); grid = -1; return; }
        int dev = 0, cus = 0, per_cu = 0;
        (void)hipGetDevice(&dev);
        (void)hipDeviceGetAttribute(&cus, hipDeviceAttributeMultiprocessorCount, dev);
        (void)hipFuncSetAttribute((const void*)fwd_kernel, hipFuncAttributeMaxDynamicSharedMemorySize, LDS_BYTES);
        (void)hipOccupancyMaxActiveBlocksPerMultiprocessor(&per_cu, (const void*)fwd_kernel, 512, LDS_BYTES);
        if (per_cu < 1) per_cu = 1;
        grid = cus * per_cu;
    }
    if (grid < 0) return;
    (void)hipMemsetAsync((char*)d_ws + WS_CTL, 0, 65536, stream);
    Args a{};
    for (int i = 0; i < 28; ++i) a.in[i] = (const float*)d_in[i];
    a.out = (float*)d_out; a.ws = (unsigned char*)d_ws;
    void* args[] = {&a};
    hipError_t e = hipLaunchCooperativeKernel((const void*)fwd_kernel, dim3(grid), dim3(512), args, LDS_BYTES, stream);
    if (e != hipSuccess) fprintf(stderr, "cooperative launch failed: %s (grid %d)\n", hipGetErrorString(e), grid);
}
```
